# Optimizing an MI355X kernel written in HIP

```python
import math
import jax, jax.numpy as jnp
from jax import lax
import numpy as np

D_MODEL = 1024
BATCH = 32
SEQ = 2048
DEPTH = 1

HEAD_DIM = 64
DIL_GROUPS = ((128, 1), (512, 4), (2048, 16))
A_HEADS_PER_GROUP = 4
A_HEADS = A_HEADS_PER_GROUP * len(DIL_GROUPS)
A_OUT = A_HEADS_PER_GROUP * HEAD_DIM
B_Q_HEADS = 8
B_KV_HEADS = 2
B_WINDOW = 128
B_OUT = B_Q_HEADS * HEAD_DIM
BLOCK = 128
N_BUCKETS = 32
MAX_DISTANCE = 2048
TOTAL_HEADS = A_HEADS + B_Q_HEADS
D_FF = 2816
EPS = 1e-6
A_QKV_W = A_HEADS * HEAD_DIM
B_KV_W = B_KV_HEADS * HEAD_DIM
SPLITS = (A_QKV_W, A_QKV_W, A_QKV_W, B_OUT, B_KV_W, B_KV_W, D_MODEL, D_MODEL)
D_IN = sum(SPLITS)

kernel_name = "hybrid_dilated_swa_sink_macaron"


def rms_norm(x, g):
    x32 = x.astype(jnp.float32)
    y = x32 * lax.rsqrt(jnp.mean(x32 * x32, axis=-1, keepdims=True) + EPS)
    return (y * g.astype(jnp.float32)).astype(x.dtype)


def swiglu(x, w_gate, w_up, w_down):
    return (jax.nn.silu(x @ w_gate) * (x @ w_up)) @ w_down


def t5_bucket(dist):
    max_exact = N_BUCKETS // 2
    n = jnp.maximum(dist, 0)
    nf = jnp.maximum(n, 1).astype(jnp.float32)
    large = max_exact + (jnp.log(nf / max_exact) / math.log(MAX_DISTANCE / max_exact)
                         * (N_BUCKETS - max_exact)).astype(jnp.int32)
    large = jnp.minimum(large, N_BUCKETS - 1)
    return jnp.where(n < max_exact, n, large)


def band_geometry(max_steps):
    qi = jnp.arange(BLOCK)[:, None]
    ki = jnp.arange(2 * BLOCK)[None, :]
    dist = qi + BLOCK - ki
    band = (dist >= 0) & (dist <= max_steps)
    return dist, band


def rel_bias_block(table, dist, stride, h0, h1):
    b = table[t5_bucket(dist * stride)][..., h0:h1]
    return jnp.transpose(b, (2, 0, 1))


def banded_attention(q, k, v, bias, max_steps, sinks=None):
    N, L, H, hd = q.shape
    hkv = k.shape[2]
    g = H // hkv
    nb = -(-L // BLOCK)
    lp = nb * BLOCK
    pad = ((0, 0), (0, lp - L), (0, 0), (0, 0))
    qb = jnp.pad(q, pad).reshape(N, nb, BLOCK, hkv, g, hd)
    kb = jnp.pad(k, pad).reshape(N, nb, BLOCK, hkv, hd)
    vb = jnp.pad(v, pad).reshape(N, nb, BLOCK, hkv, hd)

    def with_prev(t):
        prev = jnp.pad(t, ((0, 0), (1, 0), (0, 0), (0, 0), (0, 0)))[:, :-1]
        return jnp.concatenate([prev, t], axis=2)

    kc, vc = with_prev(kb), with_prev(vb)
    _, band = band_geometry(max_steps)
    first = (jnp.arange(nb) == 0)[:, None, None]
    before_start = (jnp.arange(2 * BLOCK) < BLOCK)[None, None, :]
    valid = band[None] & ~(first & before_start)

    logits = jnp.einsum('nbqhgd,nbkhd->nbhgqk', qb, kc).astype(jnp.float32) * (hd ** -0.5)
    logits = logits + bias.astype(jnp.float32).reshape(hkv, g, BLOCK, 2 * BLOCK)
    logits = jnp.where(valid[None, :, None, None], logits, -jnp.inf)
    m = jnp.max(logits, axis=-1)
    if sinks is not None:
        s = sinks.astype(jnp.float32).reshape(hkv, g)[:, :, None]
        m = jnp.maximum(m, s)
    p = jnp.exp(logits - m[..., None])
    denom = jnp.sum(p, axis=-1)
    if sinks is not None:
        denom = denom + jnp.exp(s - m)
    out = jnp.einsum('nbhgqk,nbkhd->nbqhgd', p.astype(vc.dtype), vc)
    out = (out / jnp.transpose(denom, (0, 1, 4, 2, 3))[..., None]).astype(q.dtype)
    out = out.reshape(N, lp, H, hd)[:, :L]
    lse = jnp.transpose(m + jnp.log(denom), (0, 1, 4, 2, 3)).reshape(N, lp, H)[:, :L]
    return out, lse


def fold_residues(t, d):
    B, S, H, hd = t.shape
    t = t.reshape(B, S // d, d, H, hd)
    return jnp.transpose(t, (0, 2, 1, 3, 4)).reshape(B * d, S // d, H, hd)


def unfold_residues(t, B, d):
    Bd, Ld = t.shape[:2]
    rest = t.shape[2:]
    t = t.reshape((B, d, Ld) + rest)
    perm = (0, 2, 1) + tuple(range(3, t.ndim))
    return jnp.transpose(t, perm).reshape((B, d * Ld) + rest)


def dilated_attention(q, k, v, table):
    B, S = q.shape[:2]
    outs, lses = [], []
    for gi, (window, d) in enumerate(DIL_GROUPS):
        h0, h1 = gi * A_HEADS_PER_GROUP, (gi + 1) * A_HEADS_PER_GROUP
        steps = window // d
        dist, _ = band_geometry(steps)
        bias = rel_bias_block(table, dist, d, h0, h1)
        o, lse = banded_attention(fold_residues(q[:, :, h0:h1], d), fold_residues(k[:, :, h0:h1], d),
                                  fold_residues(v[:, :, h0:h1], d), bias, steps)
        outs.append(unfold_residues(o, B, d))
        lses.append(unfold_residues(lse, B, d))
    alpha = jax.nn.softmax(jnp.stack(lses, axis=0), axis=0)
    y = jnp.sum(alpha[..., None] * jnp.stack(outs, axis=0).astype(jnp.float32), axis=0)
    return y.reshape(B, S, A_OUT).astype(q.dtype)


def sliding_window_sink_attention(q, k, v, sinks, table):
    B, S = q.shape[:2]
    dist, _ = band_geometry(B_WINDOW - 1)
    bias = rel_bias_block(table, dist, 1, A_HEADS, TOTAL_HEADS)
    o, _ = banded_attention(q, k, v, bias, B_WINDOW - 1, sinks)
    return o.reshape(B, S, B_OUT)


def hybrid_layer(x, ffn1_norm, ffn1_w_gate, ffn1_w_up, ffn1_w_down, mix_norm, w_in, b_in,
                 w_branch_a, w_branch_b, w_out, sinks, rel_bias,
                 ffn2_norm, ffn2_w_gate, ffn2_w_up, ffn2_w_down):
    B, S, _ = x.shape
    h = x + 0.5 * swiglu(rms_norm(x, ffn1_norm), ffn1_w_gate, ffn1_w_up, ffn1_w_down)
    u = rms_norm(h, mix_norm)
    z = u @ w_in + b_in
    aq, ak, av, bq, bk, bv, ga, gb = jnp.split(z, np.cumsum(SPLITS)[:-1].tolist(), axis=-1)
    heads = lambda t: t.reshape(B, S, -1, HEAD_DIM)
    ya = dilated_attention(heads(aq), heads(ak), heads(av), rel_bias)
    yb = sliding_window_sink_attention(heads(bq), heads(bk), heads(bv), sinks, rel_bias)
    merged = jax.nn.sigmoid(ga) * (ya @ w_branch_a) + jax.nn.sigmoid(gb) * (yb @ w_branch_b)
    h = h + merged @ w_out
    h = h + 0.5 * swiglu(rms_norm(h, ffn2_norm), ffn2_w_gate, ffn2_w_up, ffn2_w_down)
    return h


def setup_inputs(seed: int = 0) -> dict:
    key = jax.random.key(seed)
    ks = jax.random.split(key, 20)
    L = DEPTH

    def w(k, shape, fan_in):
        return jax.random.normal(k, shape, jnp.float32) * (fan_in ** -0.5)

    def gain(k, shape):
        return 1.0 + 0.01 * jax.random.normal(k, shape, jnp.float32)

    return {
        "x": jax.random.normal(ks[0], (BATCH, SEQ, D_MODEL), jnp.float32),
        "ffn1_norm": gain(ks[1], (L, D_MODEL)),
        "ffn1_w_gate": w(ks[2], (L, D_MODEL, D_FF), D_MODEL),
        "ffn1_w_up": w(ks[3], (L, D_MODEL, D_FF), D_MODEL),
        "ffn1_w_down": w(ks[4], (L, D_FF, D_MODEL), D_FF),
        "mix_norm": gain(ks[5], (L, D_MODEL)),
        "w_in": w(ks[6], (L, D_MODEL, D_IN), D_MODEL),
        "b_in": 0.01 * jax.random.normal(ks[7], (L, D_IN), jnp.float32),
        "w_branch_a": w(ks[8], (L, A_OUT, D_MODEL), A_OUT),
        "w_branch_b": w(ks[9], (L, B_OUT, D_MODEL), B_OUT),
        "w_out": w(ks[10], (L, D_MODEL, D_MODEL), D_MODEL),
        "sinks": 0.5 * jax.random.normal(ks[11], (L, B_Q_HEADS), jnp.float32),
        "rel_bias": 0.5 * jax.random.normal(ks[12], (N_BUCKETS, TOTAL_HEADS), jnp.float32),
        "ffn2_norm": gain(ks[13], (L, D_MODEL)),
        "ffn2_w_gate": w(ks[14], (L, D_MODEL, D_FF), D_MODEL),
        "ffn2_w_up": w(ks[15], (L, D_MODEL, D_FF), D_MODEL),
        "ffn2_w_down": w(ks[16], (L, D_FF, D_MODEL), D_FF),
        "final_norm": gain(ks[17], (D_MODEL,)),
    }


def reference(x, ffn1_norm, ffn1_w_gate, ffn1_w_up, ffn1_w_down, mix_norm, w_in, b_in,
              w_branch_a, w_branch_b, w_out, sinks, rel_bias,
              ffn2_norm, ffn2_w_gate, ffn2_w_up, ffn2_w_down, final_norm):
    h = x
    for l in range(DEPTH):
        h = hybrid_layer(h, ffn1_norm[l], ffn1_w_gate[l], ffn1_w_up[l], ffn1_w_down[l], mix_norm[l],
                         w_in[l], b_in[l], w_branch_a[l], w_branch_b[l], w_out[l], sinks[l], rel_bias,
                         ffn2_norm[l], ffn2_w_gate[l], ffn2_w_up[l], ffn2_w_down[l])
    return rms_norm(h, final_norm)
```

```cpp
#include <hip/hip_runtime.h>
#include <hip/hip_cooperative_groups.h>
#include <cstdio>
namespace cg = cooperative_groups;

#define LAS __attribute__((address_space(3)))
typedef unsigned short bf16_t;
typedef short bf16x8 __attribute__((ext_vector_type(8)));
typedef short s16x4 __attribute__((ext_vector_type(4)));
typedef float f32x4 __attribute__((ext_vector_type(4)));
typedef float f32x2 __attribute__((ext_vector_type(2)));
typedef float f32x16 __attribute__((ext_vector_type(16)));
typedef unsigned u32x4 __attribute__((ext_vector_type(4)));
typedef unsigned u32x2 __attribute__((ext_vector_type(2)));
typedef __bf16 bf16x2v __attribute__((ext_vector_type(2)));

constexpr int MTOK = 65536, DM = 1024, DFF = 2816, DIN = 5120, SEQ = 2048;
constexpr float EPS = 1e-6f, LOG2E = 1.4426950408889634f, QSCALE = 0.125f * 1.4426950408889634f, NEGBIG = -1e30f;
constexpr int ZAQ = 0, ZAK = 768, ZAV = 1536, ZBQ = 2304, ZBK = 2816, ZBV = 2944, ZGA = 3072, ZGB = 4096;
constexpr int LUTP = 192;
constexpr int LDS_BYTES = 147456 + 8 * LUTP * 4;

constexpr size_t MiB = 1u << 20;
constexpr size_t WS_WGU1 = 2 * MiB, WS_WD1 = 14 * MiB, WS_WIN = 20 * MiB, WS_WBR = 30 * MiB, WS_WOUT = 32 * MiB, WS_WGU2 = 34 * MiB, WS_WD2 = 46 * MiB;
constexpr size_t WS_LUT = 52 * MiB, WS_LSE = 53 * MiB, WS_XN = 64 * MiB, WS_YAB = 192 * MiB, WS_Z = 288 * MiB, WS_END = 928 * MiB;

__device__ __forceinline__ unsigned pk2(float lo, float hi) { f32x2 f = {lo, hi}; return __builtin_bit_cast(unsigned, __builtin_convertvector(f, bf16x2v)); }
__device__ __forceinline__ float bf_lo(unsigned u) { return __uint_as_float(u << 16); }
__device__ __forceinline__ float bf_hi(unsigned u) { return __uint_as_float(u & 0xffff0000u); }
__device__ __forceinline__ float fast_sigmoid(float v) { return __builtin_amdgcn_rcpf(1.0f + __builtin_amdgcn_exp2f(-v * LOG2E)); }

namespace pg8 {
constexpr int BM = 256, BK = 64, HALF = 128, HTB = HALF * BK * 2, STAGE_BYTES = 8 * HTB, NXCD = 8, WGM = 8;
__host__ __device__ __forceinline__ int lds_byte(int r, int c) { const int st = (r >> 4) * 2 + (c >> 5), rr = r & 15, cc = c & 31, ob = rr * 64 + cc * 2; return st * 1024 + (ob ^ (((ob >> 9) & 1) << 5)); }
__host__ __device__ __forceinline__ void stage_rc(int b, int& R, int& C) { const int st = b / 1024, sb = b % 1024, swz = sb ^ (((sb >> 9) & 1) << 5); R = (st >> 1) * 16 + swz / 64; C = (st & 1) * 32 + (swz % 64) / 2; }
__host__ __device__ __forceinline__ int perm32(int rho) { const int n = rho >> 4, i = rho & 15; return 8 * (i >> 2) + 4 * n + (i & 3); }
struct Unit { int pm, pn; };
struct Gemm { const bf16_t* A; const bf16_t* Bt; int M, N, K; };
struct StaticOrder {
    int nM, nN, nwg, G, c;
    __device__ void init(int M, int N, int G_, int c_) { nM = M / BM; nN = N / BM; nwg = nM * nN; G = G_; c = c_; }
    __device__ bool next(int i, Unit& u) const {
        const long L = (long)i * G + c; if (L >= nwg) return false;
        int wgid = (int)L; { const int q = nwg / NXCD, r = nwg % NXCD, xcd = wgid % NXCD, off = wgid / NXCD; wgid = (xcd < r ? xcd * (q + 1) : r * (q + 1) + (xcd - r) * q) + off; }
        const int nig = WGM * nN, gid = wgid / nig, fm = gid * WGM, gsz = (nM - fm) < WGM ? (nM - fm) : WGM;
        u.pm = fm + ((wgid % nig) % gsz); u.pn = (wgid % nig) / gsz; return true;
    }
};

typedef f32x4 Acc[2][2][4][2];

struct EpiSwiGLU {
    static constexpr bool PERM = true; static constexpr int MID_T = -1;
    bf16_t* O;
    __device__ __forceinline__ void mid(Acc&, const Unit&, int, int, int, int) const {}
    __device__ __forceinline__ void operator()(const Acc& acc, const Unit& u, int wr, int wc, int fr, int fq) const {
        const int row0 = u.pm * BM + wr * 64 + fr, col0 = u.pn * 128 + wc * 32 + 8 * fq;
#pragma unroll
        for (int ai = 0; ai < 2; ++ai)
#pragma unroll
            for (int m = 0; m < 4; ++m) {
                bf16_t* rowp = O + (size_t)(row0 + ai * HALF + m * 16) * DFF + col0;
                float hv[8];
#pragma unroll
                for (int n = 0; n < 2; ++n)
#pragma unroll
                    for (int j = 0; j < 4; ++j) { const float g = acc[ai][0][m][n][j], up = acc[ai][1][m][n][j]; hv[4 * n + j] = g * fast_sigmoid(g) * up; }
                u32x4 w; w.x = pk2(hv[0], hv[1]); w.y = pk2(hv[2], hv[3]); w.z = pk2(hv[4], hv[5]); w.w = pk2(hv[6], hv[7]);
                *(u32x4*)rowp = w;
            }
    }
};
struct EpiResid {
    static constexpr bool PERM = false; static constexpr int MID_T = -1;
    const float* base; float* out; float scale;
    __device__ __forceinline__ void mid(Acc&, const Unit&, int, int, int, int) const {}
    __device__ __forceinline__ void operator()(const Acc& acc, const Unit& u, int wr, int wc, int fr, int fq) const {
        const int row0 = u.pm * BM + wr * 64 + fr, col0 = u.pn * BM + wc * 32 + 4 * fq;
#pragma unroll
        for (int ai = 0; ai < 2; ++ai)
#pragma unroll
            for (int m = 0; m < 4; ++m) {
                const size_t off = (size_t)(row0 + ai * HALF + m * 16) * DM + col0;
#pragma unroll
                for (int bj = 0; bj < 2; ++bj)
#pragma unroll
                    for (int n = 0; n < 2; ++n) { const f32x4 b = *(const f32x4*)(base + off + bj * HALF + n * 16); *(f32x4*)(out + off + bj * HALF + n * 16) = b + acc[ai][bj][m][n] * scale; }
                asm volatile("" ::: "memory");
            }
    }
};
struct EpiZ {
    static constexpr bool PERM = true; static constexpr int MID_T = -1;
    bf16_t* O; const float* bias;
    __device__ __forceinline__ void mid(Acc&, const Unit&, int, int, int, int) const {}
    __device__ __forceinline__ void operator()(const Acc& acc, const Unit& u, int wr, int wc, int fr, int fq) const {
        const int row0 = u.pm * BM + wr * 64 + fr, col0 = u.pn * BM + wc * 32 + 8 * fq;
        const bool isq = (u.pn < 3) || (u.pn == 9) || (u.pn == 10), isg = (u.pn >= 12);
        const float sc = isq ? QSCALE : 1.0f;
        f32x4 bv[2][2];
#pragma unroll
        for (int bj = 0; bj < 2; ++bj)
#pragma unroll
            for (int n = 0; n < 2; ++n) bv[bj][n] = *(const f32x4*)(bias + col0 + bj * HALF + 4 * n);
#pragma unroll
        for (int ai = 0; ai < 2; ++ai)
#pragma unroll
            for (int m = 0; m < 4; ++m) {
                bf16_t* rowp = O + (size_t)(row0 + ai * HALF + m * 16) * DIN + col0;
#pragma unroll
                for (int bj = 0; bj < 2; ++bj) {
                    f32x4 v0 = (acc[ai][bj][m][0] + bv[bj][0]) * sc, v1 = (acc[ai][bj][m][1] + bv[bj][1]) * sc;
                    if (isg) {
#pragma unroll
                        for (int j = 0; j < 4; ++j) { v0[j] = fast_sigmoid(v0[j]); v1[j] = fast_sigmoid(v1[j]); }
                    }
                    u32x4 w; w.x = pk2(v0[0], v0[1]); w.y = pk2(v0[2], v0[3]); w.z = pk2(v1[0], v1[1]); w.w = pk2(v1[2], v1[3]);
                    *(u32x4*)(rowp + bj * HALF) = w;
                }
            }
    }
};
struct EpiMerge {
    static constexpr bool PERM = true; static constexpr int MID_T = 2;
    bf16_t* O; const bf16_t* Z;
    __device__ __forceinline__ void mid(Acc& acc, const Unit& u, int wr, int wc, int fr, int fq) const {
        int opq; asm volatile("v_mov_b32 %0, 0" : "=v"(opq));
        const int row0 = u.pm * BM + wr * 64 + fr + opq, col0 = u.pn * BM + wc * 32 + 8 * fq;
#pragma unroll
        for (int ai = 0; ai < 2; ++ai)
#pragma unroll
            for (int m = 0; m < 4; ++m) {
                const bf16_t* zr = Z + (size_t)(row0 + ai * HALF + m * 16) * DIN + col0;
#pragma unroll
                for (int bj = 0; bj < 2; ++bj) {
                    const u32x4 sa = *(const u32x4*)(zr + ZGA + bj * HALF), sb = *(const u32x4*)(zr + ZGB + bj * HALF);
#pragma unroll
                    for (int q = 0; q < 4; ++q) {
                        const float a0 = bf_lo(sa[q]), a1 = bf_hi(sa[q]), b0 = fmaxf(bf_lo(sb[q]), 1e-30f), b1 = fmaxf(bf_hi(sb[q]), 1e-30f);
                        acc[ai][bj][m][q >> 1][(q & 1) * 2] *= a0 * __builtin_amdgcn_rcpf(b0);
                        acc[ai][bj][m][q >> 1][(q & 1) * 2 + 1] *= a1 * __builtin_amdgcn_rcpf(b1);
                    }
                    asm volatile("" : "+v"(acc[ai][bj][m][0]), "+v"(acc[ai][bj][m][1]) :: "memory");
                }
            }
    }
    __device__ __forceinline__ void operator()(const Acc& acc, const Unit& u, int wr, int wc, int fr, int fq) const {
        const int row0 = u.pm * BM + wr * 64 + fr, col0 = u.pn * BM + wc * 32 + 8 * fq;
#pragma unroll
        for (int ai = 0; ai < 2; ++ai)
#pragma unroll
            for (int m = 0; m < 4; ++m) {
                const bf16_t* zr = Z + (size_t)(row0 + ai * HALF + m * 16) * DIN + col0;
                bf16_t* rowp = O + (size_t)(row0 + ai * HALF + m * 16) * DM + col0;
#pragma unroll
                for (int bj = 0; bj < 2; ++bj) {
                    const u32x4 sb = *(const u32x4*)(zr + ZGB + bj * HALF);
                    float o[8];
#pragma unroll
                    for (int q = 0; q < 4; ++q) {
                        o[2 * q] = acc[ai][bj][m][q >> 1][(q & 1) * 2] * fmaxf(bf_lo(sb[q]), 1e-30f);
                        o[2 * q + 1] = acc[ai][bj][m][q >> 1][(q & 1) * 2 + 1] * fmaxf(bf_hi(sb[q]), 1e-30f);
                    }
                    u32x4 w; w.x = pk2(o[0], o[1]); w.y = pk2(o[2], o[3]); w.z = pk2(o[4], o[5]); w.w = pk2(o[6], o[7]);
                    *(u32x4*)(rowp + bj * HALF) = w;
                    asm volatile("" ::: "memory");
                }
            }
    }
};

template <class Epi>
__device__ __forceinline__ void gemm_phase(LAS unsigned char* lds, const Gemm g, const StaticOrder& S, const Epi& E) {
    const int tid = threadIdx.x, wid = __builtin_amdgcn_readfirstlane(tid >> 6), lane = tid & 63, wr = wid >> 2, wc = wid & 3, fr = lane & 15, fq = lane >> 4;
    const int K = g.K, nt = K / BK;
    unsigned voffA[2], voffB[2];
#pragma unroll
    for (int i = 0; i < 2; ++i) { int R, C; stage_rc(tid * 16 + i * 8192, R, C); const int Rb = Epi::PERM ? ((R & ~31) + perm32(R & 31)) : R;
        voffA[i] = (unsigned)(R * K + C) * 2u; voffB[i] = (unsigned)(Rb * K + C) * 2u; }
    const size_t kstep = (size_t)(BK * 2);
    const size_t hstep = (size_t)HALF * K * 2;
    const size_t tstep = 2 * hstep;
    const unsigned ldsw = (unsigned)wid * 1024u;
    const int aoff = lds_byte(wr * 64 + fr, fq * 8), boff = lds_byte(wc * 32 + fr, fq * 8);
#define PG8_SA(b, h) (((b) * 2 + (h)) * HTB)
#define PG8_SB(b, h) ((4 + (b) * 2 + (h)) * HTB)
#define PG8_STAGE(bufoff, gbase, voff) do { _Pragma("unroll") for (int _i = 0; _i < 2; ++_i) \
        __builtin_amdgcn_global_load_lds((const unsigned*)((const char*)(gbase) + (voff)[_i]), (LAS unsigned*)(lds + (bufoff) + ldsw + _i * 8192), 16, 0, 0); } while (0)
#define PG8_LDA(dst, b, h) do { _Pragma("unroll") for (int m = 0; m < 4; ++m) _Pragma("unroll") for (int k = 0; k < 2; ++k) dst[m][k] = *(const LAS bf16x8*)(lds + PG8_SA(b, h) + aoff + m * 2048 + k * 1024); } while (0)
#define PG8_LDB(dst, b, h) do { _Pragma("unroll") for (int n = 0; n < 2; ++n) _Pragma("unroll") for (int k = 0; k < 2; ++k) dst[n][k] = *(const LAS bf16x8*)(lds + PG8_SB(b, h) + boff + n * 2048 + k * 1024); } while (0)
#define PG8_MMA(ai, bj, At, Bt) do { __builtin_amdgcn_s_setprio(1); _Pragma("unroll") for (int m = 0; m < 4; ++m) _Pragma("unroll") for (int n = 0; n < 2; ++n) _Pragma("unroll") for (int k = 0; k < 2; ++k) \
        acc[ai][bj][m][n] = __builtin_amdgcn_mfma_f32_16x16x32_bf16(Bt[n][k], At[m][k], acc[ai][bj][m][n], 0, 0, 0); __builtin_amdgcn_s_setprio(0); } while (0)
#define PG8_WAIT_V(n) asm volatile("s_waitcnt vmcnt(" #n ")" ::: "memory")
#define PG8_WAIT_L(n) asm volatile("s_waitcnt lgkmcnt(" #n ")" ::: "memory")
#define PG8_BAR __builtin_amdgcn_s_barrier()
#define PG8_SCHED __builtin_amdgcn_sched_barrier(0)
    Unit cur, nxt; int ui = 0;
    if (!S.next(0, cur)) return;
    Acc acc;
#pragma unroll
    for (int a = 0; a < 2; ++a)
#pragma unroll
        for (int b = 0; b < 2; ++b)
#pragma unroll
            for (int m = 0; m < 4; ++m)
#pragma unroll
                for (int n = 0; n < 2; ++n) acc[a][b][m][n] = (f32x4){0.f, 0.f, 0.f, 0.f};
    bf16x8 At[4][2], B0[2][2], B1[2][2];
    const char* cA = (const char*)g.A + (size_t)cur.pm * tstep; const char* cB = (const char*)g.Bt + (size_t)cur.pn * tstep;
    PG8_STAGE(PG8_SB(0, 0), cB, voffB); PG8_STAGE(PG8_SB(0, 1), cB + hstep, voffB); PG8_STAGE(PG8_SA(0, 0), cA, voffA); PG8_STAGE(PG8_SA(0, 1), cA + hstep, voffA);
    if (wr == 1) PG8_BAR;
    PG8_WAIT_V(2); PG8_BAR;
    PG8_STAGE(PG8_SB(1, 0), cB + kstep, voffB); PG8_STAGE(PG8_SA(1, 0), cA + kstep, voffA); PG8_STAGE(PG8_SB(1, 1), cB + hstep + kstep, voffB);
    PG8_WAIT_V(6); PG8_BAR;
    for (;;) {
        const bool has_next = S.next(ui + 1, nxt);
        const char* nA = has_next ? (const char*)g.A + (size_t)nxt.pm * tstep : cA; const char* nB = has_next ? (const char*)g.Bt + (size_t)nxt.pn * tstep : cB;
        for (int t = 0; t < nt; t += 2) {
            const bool last = (t == nt - 2);
            const char* a1 = cA + (size_t)(t + 1) * kstep;
            const char* a2 = last ? nA : cA + (size_t)(t + 2) * kstep; const char* b2 = last ? nB : cB + (size_t)(t + 2) * kstep;
            const char* a3 = a2 + kstep; const char* b3 = b2 + kstep;
            PG8_LDB(B0, 0, 0); PG8_LDB(B1, 0, 1); PG8_SCHED; PG8_LDA(At, 0, 0); PG8_STAGE(PG8_SA(1, 1), a1 + hstep, voffA);
            PG8_WAIT_V(8); PG8_WAIT_L(0); PG8_BAR; PG8_MMA(0, 0, At, B0); PG8_MMA(0, 1, At, B1); PG8_BAR; PG8_SCHED;
            PG8_LDA(At, 0, 1); PG8_STAGE(PG8_SB(0, 0), b2, voffB); PG8_STAGE(PG8_SB(0, 1), b2 + hstep, voffB); PG8_STAGE(PG8_SA(0, 0), a2, voffA);
            PG8_WAIT_V(8); PG8_WAIT_L(0); PG8_BAR; PG8_MMA(1, 0, At, B0); PG8_MMA(1, 1, At, B1); PG8_BAR; PG8_SCHED;
            PG8_LDB(B0, 1, 0); PG8_LDB(B1, 1, 1); PG8_SCHED; PG8_LDA(At, 1, 0); PG8_STAGE(PG8_SA(0, 1), a2 + hstep, voffA);
            PG8_WAIT_V(8); PG8_WAIT_L(0); PG8_BAR; PG8_MMA(0, 0, At, B0); PG8_MMA(0, 1, At, B1); PG8_BAR; PG8_SCHED;
            PG8_LDA(At, 1, 1); PG8_STAGE(PG8_SB(1, 0), b3, voffB); PG8_STAGE(PG8_SB(1, 1), b3 + hstep, voffB); PG8_STAGE(PG8_SA(1, 0), a3, voffA);
            PG8_WAIT_V(8); PG8_WAIT_L(0); PG8_BAR; PG8_MMA(1, 0, At, B0); PG8_MMA(1, 1, At, B1); PG8_BAR; PG8_SCHED;
            if constexpr (Epi::MID_T >= 0) { if (t == Epi::MID_T) { E.mid(acc, cur, wr, wc, fr, fq); PG8_SCHED; } }
        }
        if (wr == 0) PG8_BAR;
        E(acc, cur, wr, wc, fr, fq);
        if (!has_next) break;
#pragma unroll
        for (int a = 0; a < 2; ++a)
#pragma unroll
            for (int b = 0; b < 2; ++b)
#pragma unroll
                for (int m = 0; m < 4; ++m)
#pragma unroll
                    for (int n = 0; n < 2; ++n) acc[a][b][m][n] = (f32x4){0.f, 0.f, 0.f, 0.f};
        cur = nxt; cA = nA; cB = nB; ++ui;
        if (wr == 1) PG8_BAR;
    }
    PG8_WAIT_V(0);
    PG8_BAR;
#undef PG8_SA
#undef PG8_SB
#undef PG8_STAGE
#undef PG8_LDA
#undef PG8_LDB
#undef PG8_MMA
#undef PG8_WAIT_V
#undef PG8_WAIT_L
#undef PG8_BAR
#undef PG8_SCHED
}
}

__device__ __forceinline__ float wave_sum(float v) {
#pragma unroll
    for (int o = 1; o < 64; o <<= 1) v += __shfl_xor(v, o);
    return v;
}
__device__ __forceinline__ void transpose_item(const float* W, int N, const float* gain, bf16_t* WT, int ldk, int koff, int drow0, int k0, int n0, LAS float* scr, int lane) {
#pragma unroll 8
    for (int i = 0; i < 32; ++i) { const int kk = 2 * i + (lane >> 5); float v = W[(size_t)(k0 + kk) * N + n0 + (lane & 31)]; if (gain) v *= gain[k0 + kk]; scr[kk * 33 + (lane & 31)] = v; }
    asm volatile("s_waitcnt lgkmcnt(0)" ::: "memory");
    const int c = lane & 7;
#pragma unroll
    for (int j = 0; j < 4; ++j) { const int n = (lane >> 3) + 8 * j; const LAS float* s = scr + (8 * c) * 33 + n;
        u32x4 o; o.x = pk2(s[0 * 33], s[1 * 33]); o.y = pk2(s[2 * 33], s[3 * 33]); o.z = pk2(s[4 * 33], s[5 * 33]); o.w = pk2(s[6 * 33], s[7 * 33]);
        *(u32x4*)(WT + (size_t)(drow0 + n) * ldk + koff + k0 + 8 * c) = o; }
    asm volatile("s_waitcnt lgkmcnt(0)" ::: "memory");
}

struct Params {
    const float* in[18];
    float* out;
    unsigned char* ws;
};

__device__ __forceinline__ void norm_rows_bf16(const float* src, bf16_t* dst, int gw, int ngw, int lane) {
    for (int m = gw; m < MTOK; m += ngw) {
        const f32x4* xr = (const f32x4*)(src + (size_t)m * DM) + lane;
        f32x4 v[4]; float s = 0.f;
#pragma unroll
        for (int j = 0; j < 4; ++j) { v[j] = xr[64 * j]; s += (v[j].x * v[j].x + v[j].y * v[j].y) + (v[j].z * v[j].z + v[j].w * v[j].w); }
        const float r = 1.0f / sqrtf(wave_sum(s) * (1.0f / DM) + EPS);
        u32x2* o8 = (u32x2*)(dst + (size_t)m * DM) + lane;
#pragma unroll
        for (int j = 0; j < 4; ++j) { u32x2 w; w.x = pk2(v[j].x * r, v[j].y * r); w.y = pk2(v[j].z * r, v[j].w * r); o8[64 * j] = w; }
    }
}

__device__ __forceinline__ void attn_phase(LAS unsigned char* lds, bf16_t* Z, bf16_t* YAB, float* LSE, const float* lutg, const float* sinks, int G, int wg) {
    const int tid = threadIdx.x, wv = __builtin_amdgcn_readfirstlane(tid >> 6), lane = tid & 63, r = lane & 31, h = lane >> 5;
    LAS float* lutl = (LAS float*)(lds + 147456);
    for (int it = wg; it < 3584; it += G) {
        int isB, gi, d, bt, rs, b, hp;
        if (it < 3072) { isB = 0; gi = it >> 10; int rem = it & 1023; hp = rem & 1; rem >>= 1; d = (gi == 0) ? 1 : ((gi == 1) ? 4 : 16); const int nb = 16 / d; b = rem % nb; const int seq = rem / nb; bt = seq / d; rs = seq % d; }
        else { isB = 1; gi = 0; d = 1; hp = 0; const int rem = it - 3072; b = rem & 15; bt = rem >> 4; rs = 0; }
        const int tokbase = bt * SEQ + rs;
        const int kcol0 = isB ? ZBK : ZAK + (4 * gi + 2 * hp) * 64, vcol0 = isB ? ZBV : ZAV + (4 * gi + 2 * hp) * 64;
        __syncthreads();
        {
            const int ch = tid & 7, rw = tid >> 3;
            u32x4 tmp[16];
#pragma unroll
            for (int i = 0; i < 16; ++i) { const int mat = i >> 2, ii = i & 3, row = rw + 64 * ii;
                if (b > 0 || ii >= 2) { const int p = (b - 1) * 128 + row; const int tok = tokbase + d * p; const int col = ((mat < 2) ? kcol0 : vcol0) + (mat & 1) * 64 + ch * 8;
                    tmp[i] = *(const u32x4*)(Z + (size_t)tok * DIN + col); } }
#pragma unroll
            for (int i = 0; i < 16; ++i) { const int mat = i >> 2, ii = i & 3, row = rw + 64 * ii;
                if (b > 0 || ii >= 2) *(LAS u32x4*)(lds + mat * 36864 + row * 144 + ch * 16) = tmp[i]; }
            const int nh = isB ? 8 : 2, headbase = isB ? 12 : 4 * gi + 2 * hp;
            for (int idx = tid; idx < nh * LUTP; idx += 512) lutl[idx] = lutg[headbase * LUTP + idx];
        }
        __syncthreads();
        const int nrounds = isB ? 4 : 1;
        for (int rd = 0; rd < nrounds; ++rd) {
            int slot, rt, qcol, lh, qh = 0; float sink = NEGBIG;
            if (!isB) { slot = wv >> 2; rt = wv & 3; qcol = ZAQ + (4 * gi + 2 * hp + slot) * 64; lh = slot; }
            else { const int tk = rd * 8 + wv; qh = tk >> 2; rt = tk & 3; slot = qh >> 2; qcol = ZBQ + qh * 64; lh = qh; sink = sinks[qh] * LOG2E; }
            const int qi = 32 * rt + r;
            const size_t qtok = (size_t)(tokbase + d * (b * 128 + qi));
            const bf16_t* qp = Z + qtok * DIN + qcol + 8 * h;
            bf16x8 qf[4];
#pragma unroll
            for (int s = 0; s < 4; ++s) qf[s] = *(const bf16x8*)(qp + 16 * s);
            const LAS unsigned char* Ks = lds + slot * 36864;
            const LAS unsigned char* Vs = lds + 73728 + slot * 36864;
            const int dk_start = (b == 0) ? ((4 - rt) > 0 ? (4 - rt) : 0) : 0;
            f32x16 X[5];
#pragma unroll
            for (int dk = 0; dk < 5; ++dk) {
                if (dk >= dk_start) {
                    const int kt = rt + dk;
                    const LAS unsigned char* kp = Ks + (32 * kt + r) * 144 + 16 * h;
                    f32x16 x;
#pragma unroll
                    for (int i = 0; i < 16; ++i) x[i] = 0.f;
#pragma unroll
                    for (int s = 0; s < 4; ++s) { const bf16x8 kf = *(const LAS bf16x8*)(kp + 32 * s); x = __builtin_amdgcn_mfma_f32_32x32x16_bf16(kf, qf[s], x, 0, 0, 0); }
                    const LAS float* lp = lutl + lh * LUTP + 32 + 128 - 32 * dk + r - 4 * h;
#pragma unroll
                    for (int i = 0; i < 16; ++i) x[i] += lp[-((i & 3) + 8 * (i >> 2))];
                    X[dk] = x;
                } else {
#pragma unroll
                    for (int i = 0; i < 16; ++i) X[dk][i] = NEGBIG;
                }
            }
            float mx = NEGBIG;
#pragma unroll
            for (int dk = 0; dk < 5; ++dk)
#pragma unroll
                for (int i = 0; i < 16; ++i) mx = fmaxf(mx, X[dk][i]);
            mx = fmaxf(mx, __shfl_xor(mx, 32));
            mx = fmaxf(mx, sink);
            float l = 0.f;
#pragma unroll
            for (int dk = 0; dk < 5; ++dk)
#pragma unroll
                for (int i = 0; i < 16; ++i) { const float p = __builtin_amdgcn_exp2f(X[dk][i] - mx); X[dk][i] = p; l += p; }
            l += __shfl_xor(l, 32);
            if (isB) l += __builtin_amdgcn_exp2f(sink - mx);
            f32x16 O[2];
#pragma unroll
            for (int i = 0; i < 16; ++i) { O[0][i] = 0.f; O[1][i] = 0.f; }
            const int i16 = lane & 15, tq = i16 >> 2, tp = i16 & 3;
            const LAS unsigned char* vbase = Vs + (4 * h + tq) * 144 + 32 * ((lane >> 4) & 1) + 8 * tp;
#pragma unroll
            for (int dk = 0; dk < 5; ++dk) {
                if (dk >= dk_start) {
                    const int kt = rt + dk;
#pragma unroll
                    for (int s = 0; s < 2; ++s) {
                        u32x4 pw; pw.x = pk2(X[dk][8 * s + 0], X[dk][8 * s + 1]); pw.y = pk2(X[dk][8 * s + 2], X[dk][8 * s + 3]); pw.z = pk2(X[dk][8 * s + 4], X[dk][8 * s + 5]); pw.w = pk2(X[dk][8 * s + 6], X[dk][8 * s + 7]);
                        const bf16x8 pf = __builtin_bit_cast(bf16x8, pw);
#pragma unroll
                        for (int dt = 0; dt < 2; ++dt) {
                            const LAS unsigned char* va = vbase + (32 * kt + 16 * s) * 144 + 64 * dt;
                            const s16x4 lo = __builtin_amdgcn_ds_read_tr16_b64_v4i16((LAS s16x4*)(va));
                            const s16x4 hi = __builtin_amdgcn_ds_read_tr16_b64_v4i16((LAS s16x4*)(va + 8 * 144));
                            const bf16x8 vf = __builtin_shufflevector(lo, hi, 0, 1, 2, 3, 4, 5, 6, 7);
                            O[dt] = __builtin_amdgcn_mfma_f32_32x32x16_bf16(vf, pf, O[dt], 0, 0, 0);
                        }
                    }
                }
            }
            const float inv = 1.0f / l;
            bf16_t* op = isB ? (YAB + qtok * 768 + 256 + qh * 64) : (Z + qtok * DIN + qcol);
#pragma unroll
            for (int dt = 0; dt < 2; ++dt)
#pragma unroll
                for (int g4 = 0; g4 < 4; ++g4) { u32x2 w; w.x = pk2(O[dt][4 * g4] * inv, O[dt][4 * g4 + 1] * inv); w.y = pk2(O[dt][4 * g4 + 2] * inv, O[dt][4 * g4 + 3] * inv);
                    *(u32x2*)(op + 32 * dt + 8 * g4 + 4 * h) = w; }
            if (!isB && h == 0) LSE[((size_t)gi * MTOK + qtok) * 4 + 2 * hp + slot] = mx + __builtin_amdgcn_logf(l);
        }
    }
}

__device__ __forceinline__ void combine_phase(const bf16_t* Z, const float* LSE, bf16_t* YAB, long gtid, long nth) {
    for (long idx = gtid; idx < (long)MTOK * 32; idx += nth) {
        const long tok = idx >> 5; const int c = (int)(idx & 31), s = c >> 3, e0 = (c & 7) * 8;
        const float l0 = LSE[((size_t)0 * MTOK + tok) * 4 + s], l1 = LSE[((size_t)1 * MTOK + tok) * 4 + s], l2 = LSE[((size_t)2 * MTOK + tok) * 4 + s];
        const float mx = fmaxf(l0, fmaxf(l1, l2));
        const float w0 = __builtin_amdgcn_exp2f(l0 - mx), w1 = __builtin_amdgcn_exp2f(l1 - mx), w2 = __builtin_amdgcn_exp2f(l2 - mx);
        const float inv = 1.0f / (w0 + w1 + w2);
        const float a0 = w0 * inv, a1 = w1 * inv, a2 = w2 * inv;
        const bf16_t* zr = Z + (size_t)tok * DIN + s * 64 + e0;
        const u32x4 o0 = *(const u32x4*)(zr), o1 = *(const u32x4*)(zr + 256), o2 = *(const u32x4*)(zr + 512);
        u32x4 w;
#pragma unroll
        for (int q = 0; q < 4; ++q) {
            const float lo = a0 * bf_lo(o0[q]) + a1 * bf_lo(o1[q]) + a2 * bf_lo(o2[q]);
            const float hi = a0 * bf_hi(o0[q]) + a1 * bf_hi(o1[q]) + a2 * bf_hi(o2[q]);
            w[q] = pk2(lo, hi);
        }
        *(u32x4*)(YAB + (size_t)tok * 768 + s * 64 + e0) = w;
    }
}

#ifndef PHASE_MASK
#define PHASE_MASK 0xFFFFu
#endif
#define PH(k) ((PHASE_MASK >> (k)) & 1u)

__global__ void __launch_bounds__(512, 2) fwd_kernel(Params p) {
    extern __shared__ __attribute__((aligned(16))) unsigned char lds_raw[];
    LAS unsigned char* lds = (LAS unsigned char*)lds_raw;
    cg::grid_group grid = cg::this_grid();
    const int tid = threadIdx.x, lane = tid & 63, wave = __builtin_amdgcn_readfirstlane(tid >> 6);
    const int G = gridDim.x, wg = blockIdx.x;
    const int gw = wg * 8 + wave, ngw = G * 8;
    unsigned char* ws = p.ws;
    const float* x = p.in[0];
    float* out = p.out;
    bf16_t* Wgu1 = (bf16_t*)(ws + WS_WGU1); bf16_t* Wd1 = (bf16_t*)(ws + WS_WD1); bf16_t* Win = (bf16_t*)(ws + WS_WIN); bf16_t* Wbr = (bf16_t*)(ws + WS_WBR);
    bf16_t* Wout = (bf16_t*)(ws + WS_WOUT); bf16_t* Wgu2 = (bf16_t*)(ws + WS_WGU2); bf16_t* Wd2 = (bf16_t*)(ws + WS_WD2);
    float* lutg = (float*)(ws + WS_LUT); float* LSE = (float*)(ws + WS_LSE);
    bf16_t* XN = (bf16_t*)(ws + WS_XN); bf16_t* YAB = (bf16_t*)(ws + WS_YAB); bf16_t* Z = (bf16_t*)(ws + WS_Z); bf16_t* HID = Z;

    if (PH(0)) {
        LAS float* scr = (LAS float*)(lds + wave * 16384);
        constexpr int I_GU = 16 * 88, I_DN = 44 * 32, I_IN = 16 * 160, I_BA = 4 * 32, I_BB = 8 * 32, I_OUT = 16 * 32;
        constexpr int NITEMS = 6 * I_GU + I_IN + I_BA + I_BB + I_OUT;
        for (int it = gw; it < NITEMS; it += ngw) {
            int rr = it;
            bool done = false;
#pragma unroll
            for (int f = 0; f < 4; ++f) {
                if (!done && rr < I_GU) { const int kb = rr / 88, nb = rr % 88, n0 = nb * 32; const int which = f & 1, layer = f >> 1;
                    const float* W = p.in[layer ? (which ? 15 : 14) : (which ? 3 : 2)]; const float* gain = p.in[layer ? 13 : 1];
                    transpose_item(W, DFF, gain, layer ? Wgu2 : Wgu1, DM, 0, (n0 / 128) * 256 + which * 128 + (n0 % 128), kb * 64, n0, scr, lane); done = true; }
                if (!done) rr -= I_GU;
            }
            if (done) continue;
            if (rr < I_DN) { transpose_item(p.in[4], DM, nullptr, Wd1, DFF, 0, (rr % 32) * 32, (rr / 32) * 64, (rr % 32) * 32, scr, lane); continue; } rr -= I_DN;
            if (rr < I_DN) { transpose_item(p.in[16], DM, nullptr, Wd2, DFF, 0, (rr % 32) * 32, (rr / 32) * 64, (rr % 32) * 32, scr, lane); continue; } rr -= I_DN;
            if (rr < I_IN) { transpose_item(p.in[6], DIN, p.in[5], Win, DM, 0, (rr % 160) * 32, (rr / 160) * 64, (rr % 160) * 32, scr, lane); continue; } rr -= I_IN;
            if (rr < I_BA) { transpose_item(p.in[8], DM, nullptr, Wbr, 768, 0, (rr % 32) * 32, (rr / 32) * 64, (rr % 32) * 32, scr, lane); continue; } rr -= I_BA;
            if (rr < I_BB) { transpose_item(p.in[9], DM, nullptr, Wbr, 768, 256, (rr % 32) * 32, (rr / 32) * 64, (rr % 32) * 32, scr, lane); continue; } rr -= I_BB;
            transpose_item(p.in[10], DM, nullptr, Wout, DM, 0, (rr % 32) * 32, (rr / 32) * 64, (rr % 32) * 32, scr, lane);
        }
        if (wg == 0) {
            const float* rel = p.in[12];
            for (int idx = tid; idx < 20 * LUTP; idx += 512) {
                const int hd = idx / LUTP, dist = idx % LUTP - 32;
                const int dil = (hd < 4) ? 1 : ((hd < 8) ? 4 : ((hd < 12) ? 16 : 1));
                const int maxs = (hd < 12) ? 128 : 127;
                float v = NEGBIG;
                if (dist >= 0 && dist <= maxs) {
                    const int n = dist * dil; int bucket;
                    if (n < 16) bucket = n;
                    else { const float nf = (float)n; int lg = 16 + (int)(logf(nf / 16.0f) / 4.852030263919617f * 16.0f); bucket = lg < 31 ? lg : 31; }
                    v = rel[bucket * 20 + hd] * LOG2E;
                }
                lutg[idx] = v;
            }
        }
        norm_rows_bf16(x, XN, gw, ngw, lane);
    }
    grid.sync();
    if (PH(1)) { pg8::Gemm g{XN, Wgu1, MTOK, 2 * DFF, DM}; pg8::StaticOrder S; S.init(MTOK, 2 * DFF, G, wg); pg8::EpiSwiGLU E{HID}; pg8::gemm_phase(lds, g, S, E); }
    grid.sync();
    if (PH(2)) { pg8::Gemm g{HID, Wd1, MTOK, DM, DFF}; pg8::StaticOrder S; S.init(MTOK, DM, G, wg); pg8::EpiResid E{x, out, 0.5f}; pg8::gemm_phase(lds, g, S, E); }
    grid.sync();
    if (PH(3)) norm_rows_bf16(out, XN, gw, ngw, lane);
    grid.sync();
    if (PH(4)) { pg8::Gemm g{XN, Win, MTOK, DIN, DM}; pg8::StaticOrder S; S.init(MTOK, DIN, G, wg); pg8::EpiZ E{Z, p.in[7]}; pg8::gemm_phase(lds, g, S, E); }
    grid.sync();
    if (PH(5)) attn_phase(lds, Z, YAB, LSE, lutg, p.in[11], G, wg);
    grid.sync();
    if (PH(6)) combine_phase(Z, LSE, YAB, (long)wg * 512 + tid, (long)G * 512);
    grid.sync();
    if (PH(7)) { pg8::Gemm g{YAB, Wbr, MTOK, DM, 768}; pg8::StaticOrder S; S.init(MTOK, DM, G, wg); pg8::EpiMerge E{XN, Z}; pg8::gemm_phase(lds, g, S, E); }
    grid.sync();
    if (PH(8)) { pg8::Gemm g{XN, Wout, MTOK, DM, DM}; pg8::StaticOrder S; S.init(MTOK, DM, G, wg); pg8::EpiResid E{out, out, 1.0f}; pg8::gemm_phase(lds, g, S, E); }
    grid.sync();
    if (PH(9)) norm_rows_bf16(out, XN, gw, ngw, lane);
    grid.sync();
    if (PH(10)) { pg8::Gemm g{XN, Wgu2, MTOK, 2 * DFF, DM}; pg8::StaticOrder S; S.init(MTOK, 2 * DFF, G, wg); pg8::EpiSwiGLU E{HID}; pg8::gemm_phase(lds, g, S, E); }
    grid.sync();
    if (PH(11)) { pg8::Gemm g{HID, Wd2, MTOK, DM, DFF}; pg8::StaticOrder S; S.init(MTOK, DM, G, wg); pg8::EpiResid E{out, out, 0.5f}; pg8::gemm_phase(lds, g, S, E); }
    grid.sync();
    if (PH(12)) {
        const float* gf = p.in[17];
        for (int m = gw; m < MTOK; m += ngw) {
            f32x4* xr = (f32x4*)(out + (size_t)m * DM) + lane;
            f32x4 v[4]; float s = 0.f;
#pragma unroll
            for (int j = 0; j < 4; ++j) { v[j] = xr[64 * j]; s += (v[j].x * v[j].x + v[j].y * v[j].y) + (v[j].z * v[j].z + v[j].w * v[j].w); }
            const float r = 1.0f / sqrtf(wave_sum(s) * (1.0f / DM) + EPS);
#pragma unroll
            for (int j = 0; j < 4; ++j) { const f32x4 gv = *((const f32x4*)gf + lane + 64 * j); xr[64 * j] = v[j] * r * gv; }
        }
    }
}

extern "C" void kernel_launch(void* const* d_in, const int* in_sizes, int n_in, void* d_out, int out_size, void* d_ws, size_t ws_size, hipStream_t stream) {
    static int grid = 0;
    if (grid == 0) {
        if (n_in != 18 || out_size != MTOK * DM || ws_size < WS_END) { fprintf(stderr, "kernel_launch: unexpected shapes (n_in %d out %d ws %zu)\n", n_in, out_size, ws_size); grid = -1; return; }
        int dev = 0, cus = 0, per_cu = 0;
        if (hipGetDevice(&dev) != hipSuccess || hipDeviceGetAttribute(&cus, hipDeviceAttributeMultiprocessorCount, dev) != hipSuccess) { grid = -1; return; }
        if (hipFuncSetAttribute((const void*)fwd_kernel, hipFuncAttributeMaxDynamicSharedMemorySize, LDS_BYTES) != hipSuccess) { fprintf(stderr, "hipFuncSetAttribute failed\n"); grid = -1; return; }
        if (hipOccupancyMaxActiveBlocksPerMultiprocessor(&per_cu, (const void*)fwd_kernel, 512, LDS_BYTES) != hipSuccess || per_cu < 1) per_cu = 1;
        (void)hipGetLastError();
        grid = cus * per_cu;
    }
    if (grid < 0) return;
    Params p{};
    for (int i = 0; i < 18; ++i) p.in[i] = (const float*)d_in[i];
    p.out = (float*)d_out; p.ws = (unsigned char*)d_ws;
    void* args[] = {&p};
    hipError_t e = hipLaunchCooperativeKernel((const void*)fwd_kernel, dim3(grid), dim3(512), args, LDS_BYTES, stream);
    if (e != hipSuccess) fprintf(stderr, "cooperative launch failed: %s (grid %d)\n", hipGetErrorString(e), grid);
}
```

```cpp
#include <hip/hip_runtime.h>
#include <hip/hip_cooperative_groups.h>
#include <cstdio>
namespace cg = cooperative_groups;

#define LAS __attribute__((address_space(3)))
typedef unsigned short bf16_t;
typedef short bf16x8 __attribute__((ext_vector_type(8)));
typedef short s16x4 __attribute__((ext_vector_type(4)));
typedef float f32x4 __attribute__((ext_vector_type(4)));
typedef float f32x2 __attribute__((ext_vector_type(2)));
typedef float f32x16 __attribute__((ext_vector_type(16)));
typedef unsigned u32x4 __attribute__((ext_vector_type(4)));
typedef unsigned u32x2 __attribute__((ext_vector_type(2)));
typedef __bf16 bf16x2v __attribute__((ext_vector_type(2)));

constexpr int MTOK = 65536, DM = 1024, DFF = 2816, DIN = 5120, SEQ = 2048;
constexpr float EPS = 1e-6f, LOG2E = 1.4426950408889634f, QSCALE = 0.125f * 1.4426950408889634f, NEGBIG = -1e30f;
constexpr int ZAQ = 0, ZAK = 768, ZAV = 1536, ZBQ = 2304, ZBK = 2816, ZBV = 2944, ZGA = 3072, ZGB = 4096;
constexpr size_t ZO_KA = 0, ZO_VA = (size_t)MTOK * 768, ZO_QA = (size_t)MTOK * 1536, ZO_QB = (size_t)MTOK * 2304, ZO_KVB = (size_t)MTOK * 2816, ZO_G = (size_t)MTOK * 3072;
constexpr int LUTP = 192;
constexpr int LDS_CTL_OFF = 147456 + 8 * LUTP * 4;
constexpr int LDS_BYTES = LDS_CTL_OFF + 64;

constexpr size_t MiB = 1u << 20;
constexpr size_t WS_WGU1 = 2 * MiB, WS_WD1 = 14 * MiB, WS_WIN = 20 * MiB, WS_WBR = 30 * MiB, WS_WOUT = 32 * MiB, WS_WGU2 = 34 * MiB, WS_WD2 = 46 * MiB;
constexpr size_t WS_LUT = 52 * MiB, WS_LSE = 53 * MiB, WS_RS = 56 * MiB, WS_SSQ = 57 * MiB, WS_XN = 64 * MiB, WS_HB = 192 * MiB, WS_Z = 320 * MiB, WS_END = 960 * MiB;

__device__ __forceinline__ unsigned pk2(float lo, float hi) { f32x2 f = {lo, hi}; return __builtin_bit_cast(unsigned, __builtin_convertvector(f, bf16x2v)); }
__device__ __forceinline__ float bf_lo(unsigned u) { return __uint_as_float(u << 16); }
__device__ __forceinline__ float bf_hi(unsigned u) { return __uint_as_float(u & 0xffff0000u); }
__device__ __forceinline__ float fast_sigmoid(float v) { return __builtin_amdgcn_rcpf(1.0f + __builtin_amdgcn_exp2f(-v * LOG2E)); }

__device__ __forceinline__ size_t tiled_off(int row, int col, int ktiles) {
    const int r = row & 127, c = col & 63;
    const int st = (r >> 4) * 2 + (c >> 5), ob = (r & 15) * 64 + (c & 31) * 2;
    const int byte = st * 1024 + (ob ^ (((ob >> 9) & 1) << 5));
    return ((size_t)(((row >> 8) * ktiles + (col >> 6)) * 2 + ((row >> 7) & 1))) * 8192 + (byte >> 1);
}
__device__ __forceinline__ int wslot(int x) { return (x & ~31) | ((((x >> 2) & 1) << 4) | (((x >> 3) & 3) << 2) | (x & 3)); }
__device__ __forceinline__ const char* uni_ptr(const char* p) { const unsigned long long v = (unsigned long long)p; const unsigned lo = __builtin_amdgcn_readfirstlane((unsigned)v), hi = __builtin_amdgcn_readfirstlane((unsigned)(v >> 32)); return (const char*)(((unsigned long long)hi << 32) | lo); }
namespace pg8 {
constexpr int BM = 256, BK = 64, HALF = 128, HTB = HALF * BK * 2, STAGE_BYTES = 8 * HTB, NXCD = 8, WGM = 8;
__host__ __device__ __forceinline__ int lds_byte(int r, int c) { const int st = (r >> 4) * 2 + (c >> 5), rr = r & 15, cc = c & 31, ob = rr * 64 + cc * 2; return st * 1024 + (ob ^ (((ob >> 9) & 1) << 5)); }
__host__ __device__ __forceinline__ void stage_rc(int b, int& R, int& C) { const int st = b / 1024, sb = b % 1024, swz = sb ^ (((sb >> 9) & 1) << 5); R = (st >> 1) * 16 + swz / 64; C = (st & 1) * 32 + (swz % 64) / 2; }
__host__ __device__ __forceinline__ int perm32(int rho) { const int n = rho >> 4, i = rho & 15; return 8 * (i >> 2) + 4 * n + (i & 3); }
struct Unit { int pm, pn; };
struct Gemm { const bf16_t* A; const bf16_t* Bt; int M, N, K; int lda; int a_tiled; unsigned long long* dbg; };
struct StaticOrder {
    int nM, nN, nwg, G, c;
    __device__ void init(int M, int N, int G_, int c_) { nM = M / BM; nN = N / BM; nwg = nM * nN; G = G_; c = c_; }
    __device__ bool next(int i, Unit& u) const {
        const long L = (long)i * G + c; if (L >= nwg) return false;
        int wgid = (int)L; { const int q = nwg / NXCD, r = nwg % NXCD, xcd = wgid % NXCD, off = wgid / NXCD; wgid = (xcd < r ? xcd * (q + 1) : r * (q + 1) + (xcd - r) * q) + off; }
        const int nig = WGM * nN, gid = wgid / nig, fm = gid * WGM, gsz = (nM - fm) < WGM ? (nM - fm) : WGM;
        u.pm = fm + ((wgid % nig) % gsz); u.pn = (wgid % nig) / gsz; return true;
    }
};

typedef f32x4 Acc[2][2][4][2];

struct EpiSwiGLU {
    static constexpr bool PERM = true; static constexpr int MID_T = -1;
    bf16_t* O; const float* rs;
    __device__ __forceinline__ void mid(Acc&, const Unit&, int, int, int, int) const {}
    __device__ __forceinline__ void operator()(const Acc& acc, const Unit& u, int wr, int wc, int fr, int fq) const {
        int opq; asm volatile("v_mov_b32 %0, 0" : "=v"(opq));
        const int row0 = u.pm * BM + wr * 64 + fr + opq;
        float rsv[2][4];
#pragma unroll
        for (int ai = 0; ai < 2; ++ai)
#pragma unroll
            for (int m = 0; m < 4; ++m) rsv[ai][m] = rs ? rs[row0 + ai * HALF + m * 16] : 1.0f;
#pragma unroll
        for (int ai = 0; ai < 2; ++ai)
#pragma unroll
            for (int m = 0; m < 4; ++m) {
                bf16_t* rowp = O + tiled_off(row0 + ai * HALF + m * 16, u.pn * 128 + wc * 32 + 8 * fq, DFF / 64);
                float hv[8];
#pragma unroll
                for (int n = 0; n < 2; ++n)
#pragma unroll
                    for (int j = 0; j < 4; ++j) { const float g = acc[ai][0][m][n][j] * rsv[ai][m], up = acc[ai][1][m][n][j] * rsv[ai][m]; hv[4 * n + j] = g * fast_sigmoid(g) * up; }
                u32x4 w; w.x = pk2(hv[0], hv[1]); w.y = pk2(hv[2], hv[3]); w.z = pk2(hv[4], hv[5]); w.w = pk2(hv[6], hv[7]);
                *(u32x4*)rowp = w;
            }
    }
};
template <bool BASE_F32> struct EpiHB {
    static constexpr bool PERM = true; static constexpr int MID_T = -1;
    const float* xbase; bf16_t* hb; float* ssq; float scale;
    __device__ __forceinline__ void mid(Acc&, const Unit&, int, int, int, int) const {}
    __device__ __forceinline__ void operator()(const Acc& acc, const Unit& u, int wr, int wc, int fr, int fq) const {
        int opq; asm volatile("v_mov_b32 %0, 0" : "=v"(opq));
        const int row0 = u.pm * BM + wr * 64 + fr + opq, col0 = u.pn * BM + wc * 32 + 8 * fq;
#pragma unroll
        for (int ai = 0; ai < 2; ++ai) {
            f32x4 bx[BASE_F32 ? 4 : 1][2][2]; u32x4 bh[BASE_F32 ? 1 : 4][2];
#pragma unroll
            for (int m = 0; m < 4; ++m) {
                const size_t off = (size_t)(row0 + ai * HALF + m * 16) * DM + col0;
#pragma unroll
                for (int bj = 0; bj < 2; ++bj) {
                    if constexpr (BASE_F32) { bx[m][bj][0] = *(const f32x4*)(xbase + off + bj * HALF); bx[m][bj][1] = *(const f32x4*)(xbase + off + bj * HALF + 4); }
                    else bh[m][bj] = *(const u32x4*)(hb + tiled_off(row0 + ai * HALF + m * 16, col0 + bj * HALF, DM / 64));
                }
            }
            asm volatile("" ::: "memory");
#pragma unroll
            for (int m = 0; m < 4; ++m) {
                const size_t off = (size_t)(row0 + ai * HALF + m * 16) * DM + col0;
                float sq = 0.f;
#pragma unroll
                for (int bj = 0; bj < 2; ++bj) {
                    f32x4 v0, v1;
                    if constexpr (BASE_F32) { v0 = bx[m][bj][0]; v1 = bx[m][bj][1]; }
                    else { const u32x4 b = bh[m][bj]; v0 = (f32x4){bf_lo(b.x), bf_hi(b.x), bf_lo(b.y), bf_hi(b.y)}; v1 = (f32x4){bf_lo(b.z), bf_hi(b.z), bf_lo(b.w), bf_hi(b.w)}; }
                    v0 += acc[ai][bj][m][0] * scale; v1 += acc[ai][bj][m][1] * scale;
                    sq += (v0[0] * v0[0] + v0[1] * v0[1]) + (v0[2] * v0[2] + v0[3] * v0[3]) + (v1[0] * v1[0] + v1[1] * v1[1]) + (v1[2] * v1[2] + v1[3] * v1[3]);
                    u32x4 w; w.x = pk2(v0[0], v0[1]); w.y = pk2(v0[2], v0[3]); w.z = pk2(v1[0], v1[1]); w.w = pk2(v1[2], v1[3]);
                    *(u32x4*)(hb + tiled_off(row0 + ai * HALF + m * 16, col0 + bj * HALF, DM / 64)) = w;
                }
                sq += __shfl_xor(sq, 16); sq += __shfl_xor(sq, 32);
                if (fq == 0) ssq[(size_t)(row0 + ai * HALF + m * 16) * 16 + u.pn * 4 + wc] = sq;
            }
            asm volatile("" ::: "memory");
        }
    }
};
struct EpiZ {
    static constexpr bool PERM = true; static constexpr int MID_T = -1;
    bf16_t* O; const float* bias; const float* rs;
    __device__ __forceinline__ void mid(Acc&, const Unit&, int, int, int, int) const {}
    __device__ __forceinline__ void operator()(const Acc& acc, const Unit& u, int wr, int wc, int fr, int fq) const {
        int opq; asm volatile("v_mov_b32 %0, 0" : "=v"(opq));
        const int row0 = u.pm * BM + wr * 64 + fr + opq, col0 = u.pn * BM + wc * 32 + 8 * fq;
        float rsv[2][4];
#pragma unroll
        for (int ai = 0; ai < 2; ++ai)
#pragma unroll
            for (int m = 0; m < 4; ++m) rsv[ai][m] = rs[row0 + ai * HALF + m * 16];
        const bool isq = (u.pn < 3) || (u.pn == 9) || (u.pn == 10), isg = (u.pn >= 12);
        const int pn = u.pn; size_t bo; int ld, c0;
        if (pn < 3) { bo = ZO_QA; ld = 768; c0 = pn * 256; } else if (pn < 6) { bo = ZO_KA; ld = 768; c0 = (pn - 3) * 256; } else if (pn < 9) { bo = ZO_VA; ld = 768; c0 = (pn - 6) * 256; }
        else if (pn < 11) { bo = ZO_QB; ld = 512; c0 = (pn - 9) * 256; } else if (pn == 11) { bo = ZO_KVB; ld = 256; c0 = 0; } else { bo = ZO_G; ld = 2048; c0 = (pn - 12) * 256; }
        bf16_t* blk = O + bo; const int cb = c0 + wc * 32 + 8 * fq;
        const float sc = isq ? QSCALE : 1.0f;
        f32x4 bv[2][2];
#pragma unroll
        for (int bj = 0; bj < 2; ++bj)
#pragma unroll
            for (int n = 0; n < 2; ++n) bv[bj][n] = *(const f32x4*)(bias + col0 + bj * HALF + 4 * n);
#pragma unroll
        for (int ai = 0; ai < 2; ++ai)
#pragma unroll
            for (int m = 0; m < 4; ++m) {
                bf16_t* rowp = blk + (size_t)(row0 + ai * HALF + m * 16) * ld + cb;
#pragma unroll
                for (int bj = 0; bj < 2; ++bj) {
                    f32x4 v0 = (acc[ai][bj][m][0] * rsv[ai][m] + bv[bj][0]) * sc, v1 = (acc[ai][bj][m][1] * rsv[ai][m] + bv[bj][1]) * sc;
                    if (isg) {
#pragma unroll
                        for (int j = 0; j < 4; ++j) { v0[j] = fast_sigmoid(v0[j]); v1[j] = fast_sigmoid(v1[j]); }
                    }
                    u32x4 w; w.x = pk2(v0[0], v0[1]); w.y = pk2(v0[2], v0[3]); w.z = pk2(v1[0], v1[1]); w.w = pk2(v1[2], v1[3]);
                    *(u32x4*)(rowp + bj * HALF) = w;
                }
            }
    }
};
struct EpiMerge {
    static constexpr bool PERM = true; static constexpr int MID_T = 2;
    bf16_t* O; const bf16_t* Z;
    __device__ __forceinline__ void mid(Acc& acc, const Unit& u, int wr, int wc, int fr, int fq) const {
        int opq; asm volatile("v_mov_b32 %0, 0" : "=v"(opq));
        const int row0 = u.pm * BM + wr * 64 + fr + opq, col0 = u.pn * BM + wc * 32 + 8 * fq;
#pragma unroll
        for (int ai = 0; ai < 2; ++ai) {
            u32x4 sa[4][2], sb[4][2];
#pragma unroll
            for (int m = 0; m < 4; ++m) {
                const bf16_t* zr = Z + ZO_G + (size_t)(row0 + ai * HALF + m * 16) * 2048 + col0;
#pragma unroll
                for (int bj = 0; bj < 2; ++bj) { sa[m][bj] = *(const u32x4*)(zr + bj * HALF); sb[m][bj] = *(const u32x4*)(zr + 1024 + bj * HALF); }
            }
            asm volatile("" ::: "memory");
#pragma unroll
            for (int m = 0; m < 4; ++m)
#pragma unroll
                for (int bj = 0; bj < 2; ++bj) {
#pragma unroll
                    for (int q = 0; q < 4; ++q) {
                        const float a0 = bf_lo(sa[m][bj][q]), a1 = bf_hi(sa[m][bj][q]), b0 = fmaxf(bf_lo(sb[m][bj][q]), 1e-30f), b1 = fmaxf(bf_hi(sb[m][bj][q]), 1e-30f);
                        acc[ai][bj][m][q >> 1][(q & 1) * 2] *= a0 * __builtin_amdgcn_rcpf(b0);
                        acc[ai][bj][m][q >> 1][(q & 1) * 2 + 1] *= a1 * __builtin_amdgcn_rcpf(b1);
                    }
                }
            asm volatile("" : "+v"(acc[ai][0][0][0]), "+v"(acc[ai][1][3][1]) :: "memory");
        }
    }
    __device__ __forceinline__ void operator()(const Acc& acc, const Unit& u, int wr, int wc, int fr, int fq) const {
        const int row0 = u.pm * BM + wr * 64 + fr, col0 = u.pn * BM + wc * 32 + 8 * fq;
        u32x4 sbv[2][4][2];
#pragma unroll
        for (int ai = 0; ai < 2; ++ai)
#pragma unroll
            for (int m = 0; m < 4; ++m) {
                const bf16_t* zr = Z + ZO_G + (size_t)(row0 + ai * HALF + m * 16) * 2048 + col0;
#pragma unroll
                for (int bj = 0; bj < 2; ++bj) sbv[ai][m][bj] = *(const u32x4*)(zr + 1024 + bj * HALF);
            }
        asm volatile("" ::: "memory");
#pragma unroll
        for (int ai = 0; ai < 2; ++ai)
#pragma unroll
            for (int m = 0; m < 4; ++m) {
                const int orow = row0 + ai * HALF + m * 16;
#pragma unroll
                for (int bj = 0; bj < 2; ++bj) {
                    const u32x4 sb = sbv[ai][m][bj];
                    float o[8];
#pragma unroll
                    for (int q = 0; q < 4; ++q) {
                        o[2 * q] = acc[ai][bj][m][q >> 1][(q & 1) * 2] * fmaxf(bf_lo(sb[q]), 1e-30f);
                        o[2 * q + 1] = acc[ai][bj][m][q >> 1][(q & 1) * 2 + 1] * fmaxf(bf_hi(sb[q]), 1e-30f);
                    }
                    u32x4 w; w.x = pk2(o[0], o[1]); w.y = pk2(o[2], o[3]); w.z = pk2(o[4], o[5]); w.w = pk2(o[6], o[7]);
                    *(u32x4*)(O + tiled_off(orow, col0 + bj * HALF, DM / 64)) = w;
                }
            }
    }
};

template <class Epi, bool DBGP = false>
__device__ __forceinline__ void gemm_phase(LAS unsigned char* lds, const Gemm g, const StaticOrder& S, const Epi& E) {
    int tid_o = threadIdx.x; asm volatile("" : "+v"(tid_o));
    const int tid = tid_o, wid = __builtin_amdgcn_readfirstlane(tid >> 6), lane = tid & 63, wr = wid >> 2, wc = wid & 3, fr = lane & 15, fq = lane >> 4;
    const int K = g.K, nt = K / BK;
    unsigned voffA[2], voffB[2];
#pragma unroll
    for (int i = 0; i < 2; ++i) { int R, C; stage_rc(tid * 16 + i * 8192, R, C); const int Rb = Epi::PERM ? ((R & ~31) + perm32(R & 31)) : R;
        (void)Rb; voffA[i] = g.a_tiled ? (unsigned)(tid * 16 + i * 8192) : (unsigned)(R * g.lda + C) * 2u; voffB[i] = (unsigned)(tid * 16 + i * 8192); }
    const size_t kstep = (size_t)(BM * BK * 2);
    const size_t hstep = (size_t)(HALF * BK * 2);
    const size_t tstep = (size_t)BM * K * 2;
    const size_t kstepA = g.a_tiled ? kstep : (size_t)(BK * 2), hstepA = g.a_tiled ? hstep : (size_t)HALF * g.lda * 2;
    const size_t tstepA = g.a_tiled ? tstep : 2 * hstepA;
    const unsigned ldsw = (unsigned)wid * 1024u;
    const int aoff = lds_byte(wr * 64 + fr, fq * 8), boff = lds_byte(wc * 32 + fr, fq * 8);
#define PG8_SA(b, h) (((b) * 2 + (h)) * HTB)
#define PG8_SB(b, h) ((4 + (b) * 2 + (h)) * HTB)
#define PG8_STAGE(bufoff, gbase, voff) do { _Pragma("unroll") for (int _i = 0; _i < 2; ++_i) \
        __builtin_amdgcn_global_load_lds((const unsigned*)((const char*)(gbase) + (voff)[_i]), (LAS unsigned*)(lds + (bufoff) + ldsw + _i * 8192), 16, 0, 0); } while (0)
#define PG8_LDA(dst, b, h) do { _Pragma("unroll") for (int m = 0; m < 4; ++m) _Pragma("unroll") for (int k = 0; k < 2; ++k) dst[m][k] = *(const LAS bf16x8*)(lds + PG8_SA(b, h) + aoff + m * 2048 + k * 1024); } while (0)
#define PG8_LDB(dst, b, h) do { _Pragma("unroll") for (int n = 0; n < 2; ++n) _Pragma("unroll") for (int k = 0; k < 2; ++k) dst[n][k] = *(const LAS bf16x8*)(lds + PG8_SB(b, h) + boff + n * 2048 + k * 1024); } while (0)
#define PG8_MMA(ai, bj, At, Bt) do { __builtin_amdgcn_s_setprio(1); _Pragma("unroll") for (int m = 0; m < 4; ++m) _Pragma("unroll") for (int n = 0; n < 2; ++n) _Pragma("unroll") for (int k = 0; k < 2; ++k) \
        acc[ai][bj][m][n] = __builtin_amdgcn_mfma_f32_16x16x32_bf16(Bt[n][k], At[m][k], acc[ai][bj][m][n], 0, 0, 0); __builtin_amdgcn_s_setprio(0); } while (0)
#define PG8_WAIT_V(n) asm volatile("s_waitcnt vmcnt(" #n ")" ::: "memory")
#define PG8_WAIT_L(n) asm volatile("s_waitcnt lgkmcnt(" #n ")" ::: "memory")
#define PG8_BAR __builtin_amdgcn_s_barrier()
#define PG8_SCHED __builtin_amdgcn_sched_barrier(0)
#ifndef DBG_GEMM_MODE
#define DBG_GEMM_MODE 0
#endif
    unsigned long long dbg_acc = 0, dbg_t0 = 0; (void)dbg_t0;
    Unit cur, nxt; int ui = 0;
    if (!S.next(0, cur)) return;
    Acc acc;
#pragma unroll
    for (int a = 0; a < 2; ++a)
#pragma unroll
        for (int b = 0; b < 2; ++b)
#pragma unroll
            for (int m = 0; m < 4; ++m)
#pragma unroll
                for (int n = 0; n < 2; ++n) acc[a][b][m][n] = (f32x4){0.f, 0.f, 0.f, 0.f};
    bf16x8 At[4][2], B0[2][2], B1[2][2];
    const char* cA = uni_ptr((const char*)g.A + (size_t)cur.pm * tstepA); const char* cB = uni_ptr((const char*)g.Bt + (size_t)cur.pn * tstep);
    PG8_STAGE(PG8_SB(0, 0), cB, voffB); PG8_STAGE(PG8_SB(0, 1), cB + hstep, voffB); PG8_STAGE(PG8_SA(0, 0), cA, voffA); PG8_STAGE(PG8_SA(0, 1), cA + hstepA, voffA);
    if (wr == 1) PG8_BAR;
    PG8_WAIT_V(2); PG8_BAR;
    PG8_STAGE(PG8_SB(1, 0), cB + kstep, voffB); PG8_STAGE(PG8_SA(1, 0), cA + kstepA, voffA); PG8_STAGE(PG8_SB(1, 1), cB + hstep + kstep, voffB);
    PG8_WAIT_V(6); PG8_BAR;
    for (;;) {
        const bool has_next = S.next(ui + 1, nxt);
        const char* nA = uni_ptr(has_next ? (const char*)g.A + (size_t)nxt.pm * tstepA : cA); const char* nB = uni_ptr(has_next ? (const char*)g.Bt + (size_t)nxt.pn * tstep : cB);
        if (DBG_GEMM_MODE == 3 && DBGP) dbg_t0 = __builtin_amdgcn_s_memrealtime();
        if (DBG_GEMM_MODE == 5 && DBGP && ui > 0) dbg_acc += __builtin_amdgcn_s_memrealtime() - dbg_t0;
        for (int t = 0; t < nt; t += 2) {
            if (DBG_GEMM_MODE == 2 && DBGP && t == 2) dbg_t0 = __builtin_amdgcn_s_memrealtime();
            if (DBG_GEMM_MODE == 3 && DBGP && t == 2) dbg_acc += __builtin_amdgcn_s_memrealtime() - dbg_t0;
            const bool last = (t == nt - 2);
            const char* a1 = cA + (size_t)(t + 1) * kstepA;
            const char* a2 = last ? nA : cA + (size_t)(t + 2) * kstepA; const char* b2 = last ? nB : cB + (size_t)(t + 2) * kstep;
            const char* a3 = a2 + kstepA; const char* b3 = b2 + kstep;
            PG8_LDB(B0, 0, 0); PG8_LDB(B1, 0, 1); PG8_SCHED; PG8_LDA(At, 0, 0); PG8_STAGE(PG8_SA(1, 1), a1 + hstepA, voffA);
            PG8_WAIT_V(8); PG8_WAIT_L(0); PG8_BAR; PG8_MMA(0, 0, At, B0); PG8_MMA(0, 1, At, B1); PG8_BAR; PG8_SCHED;
            PG8_LDA(At, 0, 1); PG8_STAGE(PG8_SB(0, 0), b2, voffB); PG8_STAGE(PG8_SB(0, 1), b2 + hstep, voffB); PG8_STAGE(PG8_SA(0, 0), a2, voffA);
            PG8_WAIT_V(8); PG8_WAIT_L(0); PG8_BAR; PG8_MMA(1, 0, At, B0); PG8_MMA(1, 1, At, B1); PG8_BAR; PG8_SCHED;
            PG8_LDB(B0, 1, 0); PG8_LDB(B1, 1, 1); PG8_SCHED; PG8_LDA(At, 1, 0); PG8_STAGE(PG8_SA(0, 1), a2 + hstepA, voffA);
            PG8_WAIT_V(8); PG8_WAIT_L(0); PG8_BAR; PG8_MMA(0, 0, At, B0); PG8_MMA(0, 1, At, B1); PG8_BAR; PG8_SCHED;
            PG8_LDA(At, 1, 1); PG8_STAGE(PG8_SB(1, 0), b3, voffB); PG8_STAGE(PG8_SB(1, 1), b3 + hstep, voffB); PG8_STAGE(PG8_SA(1, 0), a3, voffA);
            PG8_WAIT_V(8); PG8_WAIT_L(0); PG8_BAR; PG8_MMA(1, 0, At, B0); PG8_MMA(1, 1, At, B1); PG8_BAR; PG8_SCHED;
            if constexpr (Epi::MID_T >= 0) { if (t == Epi::MID_T) { E.mid(acc, cur, wr, wc, fr, fq); PG8_SCHED; } }
        }
        if (DBG_GEMM_MODE == 2 && DBGP) dbg_acc += __builtin_amdgcn_s_memrealtime() - dbg_t0;
        if (DBG_GEMM_MODE == 5 && DBGP) dbg_t0 = __builtin_amdgcn_s_memrealtime();
        if (wr == 0) PG8_BAR;
        if (DBG_GEMM_MODE == 1 && DBGP) dbg_t0 = __builtin_amdgcn_s_memrealtime();
        E(acc, cur, wr, wc, fr, fq);
#ifdef DBG_EPI2
        if (DBGP) { asm volatile("" ::: "memory"); E(acc, cur, wr, wc, fr, fq); }
#endif
        if (DBG_GEMM_MODE == 1 && DBGP) dbg_acc += __builtin_amdgcn_s_memrealtime() - dbg_t0;
        if (!has_next) break;
#pragma unroll
        for (int a = 0; a < 2; ++a)
#pragma unroll
            for (int b = 0; b < 2; ++b)
#pragma unroll
                for (int m = 0; m < 4; ++m)
#pragma unroll
                    for (int n = 0; n < 2; ++n) acc[a][b][m][n] = (f32x4){0.f, 0.f, 0.f, 0.f};
        cur = nxt; cA = nA; cB = nB; ++ui;
        if (wr == 1) PG8_BAR;
    }
    PG8_WAIT_V(0);
    PG8_BAR;
    if (DBG_GEMM_MODE && DBGP && blockIdx.x == 0 && tid == 0) *g.dbg = dbg_acc;
#undef PG8_SA
#undef PG8_SB
#undef PG8_STAGE
#undef PG8_LDA
#undef PG8_LDB
#undef PG8_MMA
#undef PG8_WAIT_V
#undef PG8_WAIT_L
#undef PG8_BAR
#undef PG8_SCHED
}
}

#define XB_TMO      128
#define XB_XCNT(j)  (256  + 64 * (j))
#define XB_XSUB(j)  (1280 + 64 * (j))
#define XB_XGEN(j)  (2304 + 64 * (j))
#define XB_TOP      3328
#define XB_TOPGEN   3392
#define XCD_BAR_WORDS 3456
#define XB_SPIN_CAP (1u << 18)

__device__ __forceinline__ unsigned xb_ld(unsigned* p)              { return __hip_atomic_load(p, __ATOMIC_RELAXED, __HIP_MEMORY_SCOPE_AGENT); }
__device__ __forceinline__ unsigned xb_add(unsigned* p, unsigned v) { return __hip_atomic_fetch_add(p, v, __ATOMIC_RELAXED, __HIP_MEMORY_SCOPE_AGENT); }
__device__ __forceinline__ unsigned xb_xcc_id() { return (unsigned)__builtin_amdgcn_s_getreg((3 << 11) | 20) & 0xFu; }
#define XB_SPIN(cond, bar) do { unsigned _sp = 0; while (cond) { __builtin_amdgcn_s_sleep(1); \
    if ((++_sp & 255u) == 0u) { if (xb_ld(&(bar)[XB_TMO])) break; if (_sp > XB_SPIN_CAP) { atomicAdd(&(bar)[XB_TMO], 1u); break; } } } } while (0)

struct XcdBarrier {
    unsigned* bar; unsigned x;
    volatile LAS unsigned* st;
};

__device__ __forceinline__ XcdBarrier xcd_barrier_post(unsigned* bar, volatile LAS unsigned* st) {
    XcdBarrier b; b.bar = bar; b.x = xb_xcc_id(); b.st = st;
    if (threadIdx.x == 0) (void)xb_add(&bar[XB_XCNT(b.x)], 1u);
    return b;
}
__device__ __forceinline__ void xcd_barrier_complete(unsigned* bar, unsigned x, unsigned& nloc, unsigned& nx) {
    const unsigned G = gridDim.x * gridDim.y * gridDim.z;
    unsigned sum, cnt, mine, sp = 0u;
    for (;;) {
        sum = 0u; cnt = 0u; mine = 0u;
#pragma unroll
        for (unsigned j = 0; j < 16; ++j) { const unsigned c = xb_ld(&bar[XB_XCNT(j)]); sum += c; cnt += (c > 0u) ? 1u : 0u; mine = (j == x) ? c : mine; }
        if (sum == G) break;
        __builtin_amdgcn_s_sleep(1);
        if ((++sp & 255u) == 0u) { if (xb_ld(&bar[XB_TMO])) break; if (sp > XB_SPIN_CAP) { atomicAdd(&bar[XB_TMO], 1u); break; } }
    }
    nloc = mine > 0u ? mine : 1u; nx = cnt > 0u ? cnt : 1u;
}

__device__ __forceinline__ void xcd_barrier(const XcdBarrier& b) {
    asm volatile("s_waitcnt vmcnt(0)" ::: "memory");
    __syncthreads();
    if (threadIdx.x == 0) {
        unsigned* bar = b.bar;
        __builtin_amdgcn_s_waitcnt(0);
        unsigned nloc = b.st[0], nx = b.st[1];
        if (nloc == 0u) { xcd_barrier_complete(bar, b.x, nloc, nx); b.st[0] = nloc; b.st[1] = nx; }
        const unsigned old = xb_add(&bar[XB_XSUB(b.x)], 1u);
        const unsigned gen = old / nloc;
        if (old + 1u == (gen + 1u) * nloc) {
            __builtin_amdgcn_fence(__ATOMIC_RELEASE, "agent");
            asm volatile("s_waitcnt vmcnt(0)" ::: "memory");
            const unsigned og = xb_add(&bar[XB_TOP], 1u);
            const unsigned tg = og / nx;
            if (og + 1u == (tg + 1u) * nx) xb_add(&bar[XB_TOPGEN], 1u);
            else XB_SPIN(xb_ld(&bar[XB_TOPGEN]) == tg, bar);
            __builtin_amdgcn_fence(__ATOMIC_ACQUIRE, "agent");
            xb_add(&bar[XB_XGEN(b.x)], 1u);
            asm volatile("s_waitcnt vmcnt(0)" ::: "memory");
        } else {
            XB_SPIN(xb_ld(&bar[XB_XGEN(b.x)]) == gen, bar);
            __builtin_amdgcn_fence(__ATOMIC_ACQUIRE, "agent");
            asm volatile("s_waitcnt vmcnt(0)" ::: "memory");
        }
    }
    __syncthreads();
}


__device__ __forceinline__ int otid() { int t = threadIdx.x; asm volatile("" : "+v"(t)); return t; }
__device__ __forceinline__ float wave_sum(float v) {
#pragma unroll
    for (int o = 1; o < 64; o <<= 1) v += __shfl_xor(v, o);
    return v;
}
__device__ __forceinline__ void transpose_item(const float* W, int N, const float* gain, bf16_t* WT, int ldk, int koff, int drow0, int k0, int n0, LAS float* scr, int lane) {
    const f32x4* src = (const f32x4*)(W + (size_t)(k0 + lane) * N + n0);
    f32x4 v[8];
#pragma unroll
    for (int j = 0; j < 8; ++j) v[j] = src[j];
    const float gsc = gain ? gain[k0 + lane] : 1.0f;
#pragma unroll
    for (int j = 0; j < 8; ++j) { scr[lane * 33 + 4 * j + 0] = v[j].x * gsc; scr[lane * 33 + 4 * j + 1] = v[j].y * gsc; scr[lane * 33 + 4 * j + 2] = v[j].z * gsc; scr[lane * 33 + 4 * j + 3] = v[j].w * gsc; }
    asm volatile("s_waitcnt lgkmcnt(0)" ::: "memory");
    const int c = lane & 7;
#pragma unroll
    for (int j = 0; j < 4; ++j) { const int n = (lane >> 3) + 8 * j; const LAS float* sp = scr + (8 * c) * 33 + n;
        u32x4 o; o.x = pk2(sp[0 * 33], sp[1 * 33]); o.y = pk2(sp[2 * 33], sp[3 * 33]); o.z = pk2(sp[4 * 33], sp[5 * 33]); o.w = pk2(sp[6 * 33], sp[7 * 33]);
        *(u32x4*)(WT + tiled_off(wslot(drow0 + n), koff + k0 + 8 * c, ldk >> 6)) = o; }
    asm volatile("s_waitcnt lgkmcnt(0)" ::: "memory");
}

struct Params {
    const float* in[18];
    float* out;
    unsigned char* ws;
};

__device__ __forceinline__ void norm_rows_bf16(const float* src, bf16_t* dst, int gw, int ngw, int lane) {
    for (int m = 2 * gw; m < MTOK; m += 2 * ngw) {
        const f32x4* xr = (const f32x4*)(src + (size_t)m * DM) + lane;
        f32x4 v[2][4]; float s0 = 0.f, s1 = 0.f;
#pragma unroll
        for (int j = 0; j < 4; ++j) { v[0][j] = xr[64 * j]; v[1][j] = xr[256 + 64 * j]; }
#pragma unroll
        for (int j = 0; j < 4; ++j) { s0 += (v[0][j].x * v[0][j].x + v[0][j].y * v[0][j].y) + (v[0][j].z * v[0][j].z + v[0][j].w * v[0][j].w);
                                      s1 += (v[1][j].x * v[1][j].x + v[1][j].y * v[1][j].y) + (v[1][j].z * v[1][j].z + v[1][j].w * v[1][j].w); }
        const float r0 = 1.0f / sqrtf(wave_sum(s0) * (1.0f / DM) + EPS), r1 = 1.0f / sqrtf(wave_sum(s1) * (1.0f / DM) + EPS);
#pragma unroll
        for (int j = 0; j < 4; ++j) { u32x2 w; w.x = pk2(v[0][j].x * r0, v[0][j].y * r0); w.y = pk2(v[0][j].z * r0, v[0][j].w * r0); *(u32x2*)(dst + tiled_off(m, 4 * lane + 256 * j, DM / 64)) = w;
                                      u32x2 w1; w1.x = pk2(v[1][j].x * r1, v[1][j].y * r1); w1.y = pk2(v[1][j].z * r1, v[1][j].w * r1); *(u32x2*)(dst + tiled_off(m + 1, 4 * lane + 256 * j, DM / 64)) = w1; }
    }
}
__device__ __forceinline__ void rowscale_phase(const float* ssq, float* rs, int gtid, int nth) {
    for (int row = gtid; row < MTOK; row += nth) {
        const f32x4* pp = (const f32x4*)(ssq + (size_t)row * 16);
        const f32x4 a = pp[0], b = pp[1], c = pp[2], d = pp[3];
        const float sum = ((a.x + a.y) + (a.z + a.w)) + ((b.x + b.y) + (b.z + b.w)) + ((c.x + c.y) + (c.z + c.w)) + ((d.x + d.y) + (d.z + d.w));
        rs[row] = 1.0f / sqrtf(sum * (1.0f / DM) + EPS);
    }
}

__device__ __forceinline__ void attn_load_block(LAS unsigned char* lds, const bf16_t* kp0, const bf16_t* vp0, int kvld, int tokbase, int d, int blk, int tid) {
    const int ch = tid & 7, rw = tid >> 3;
    u32x4 tmp[8];
#pragma unroll
    for (int i = 0; i < 8; ++i) { const int mat = i >> 1, row = rw + 64 * (i & 1); const int tok = tokbase + d * (blk * 128 + row);
        tmp[i] = *(const u32x4*)(((mat < 2) ? kp0 : vp0) + (size_t)tok * kvld + (mat & 1) * 64 + ch * 8); }
#pragma unroll
    for (int i = 0; i < 8; ++i) { const int mat = i >> 1, row = (blk & 1) * 128 + rw + 64 * (i & 1); *(LAS u32x4*)(lds + mat * 36864 + row * 144 + ch * 16) = tmp[i]; }
}
#define ATT_BAR() do { asm volatile("s_waitcnt lgkmcnt(0)" ::: "memory"); __builtin_amdgcn_s_barrier(); asm volatile("" ::: "memory"); } while (0)
__device__ __forceinline__ void attn_phase(LAS unsigned char* lds, bf16_t* Z, bf16_t* YAB, float* LSE, const float* lutg, const float* sinks, int G, int wg) {
    int tid_o = threadIdx.x; asm volatile("" : "+v"(tid_o));
    const int tid = tid_o, wv = __builtin_amdgcn_readfirstlane(tid >> 6), lane = tid & 63, r = lane & 31, h = lane >> 5;
    LAS float* lutl = (LAS float*)(lds + 147456);
    for (int sid = wg; sid < 1792; sid += G) {
        int isB, gi, d, hp, bt, rs, b0, len;
        if (sid < 256) { isB = 0; gi = 0; d = 1; const int chain = sid >> 2; hp = chain & 1; bt = chain >> 1; rs = 0; b0 = (sid & 3) * 4; len = 4; }
        else if (sid < 512) { const int c = sid - 256; isB = 0; gi = 1; d = 4; hp = c & 1; const int seq = c >> 1; bt = seq >> 2; rs = seq & 3; b0 = 0; len = 4; }
        else if (sid < 1536) { const int c = sid - 512; isB = 0; gi = 2; d = 16; hp = c & 1; const int seq = c >> 1; bt = seq >> 4; rs = seq & 15; b0 = 0; len = 1; }
        else { const int c = sid - 1536; isB = 1; gi = 0; d = 1; hp = 0; bt = c >> 3; rs = 0; b0 = (c & 7) * 2; len = 2; }
        const int tokbase = bt * SEQ + rs;
        const bf16_t* kp0 = isB ? (Z + ZO_KVB) : (Z + ZO_KA + (4 * gi + 2 * hp) * 64); const bf16_t* vp0 = isB ? (Z + ZO_KVB + 128) : (Z + ZO_VA + (4 * gi + 2 * hp) * 64);
        const int kvld = isB ? 256 : 768, qld = isB ? 512 : 768;
        for (int b = b0; b < b0 + len; ++b) {
        ATT_BAR();
        if (b == b0) {
            if (b0 > 0) attn_load_block(lds, kp0, vp0, kvld, tokbase, d, b0 - 1, tid);
            const int nh = isB ? 8 : 2, headbase = isB ? 12 : 4 * gi + 2 * hp;
            for (int idx = tid; idx < nh * LUTP; idx += 512) lutl[idx] = lutg[headbase * LUTP + idx];
        }
        attn_load_block(lds, kp0, vp0, kvld, tokbase, d, b, tid);
        ATT_BAR();
        const int nrounds = isB ? 4 : 1;
        for (int rd = 0; rd < nrounds; ++rd) {
            int slot, rt, qcol, lh, qh = 0; float sink = NEGBIG;
            if (!isB) { slot = wv >> 2; rt = wv & 3; qcol = (4 * gi + 2 * hp + slot) * 64; lh = slot; }
            else { const int tk = rd * 8 + wv; qh = tk >> 2; rt = tk & 3; slot = qh >> 2; qcol = qh * 64; lh = qh; sink = sinks[qh] * LOG2E; }
            bf16_t* qbase = Z + (isB ? ZO_QB : ZO_QA) + qcol;
            const int qi = 32 * rt + r;
            const size_t qtok = (size_t)(tokbase + d * (b * 128 + qi));
            const bf16_t* qp = qbase + qtok * qld + 8 * h;
            bf16x8 qf[4];
#pragma unroll
            for (int s = 0; s < 4; ++s) qf[s] = *(const bf16x8*)(qp + 16 * s);
            const LAS unsigned char* Ks = lds + slot * 36864;
            const LAS unsigned char* Vs = lds + 73728 + slot * 36864;
            const int dk_start = (b == 0) ? ((4 - rt) > 0 ? (4 - rt) : 0) : 0;
            f32x16 X[5];
            if (dk_start == 0) {
#pragma unroll
                for (int dk = 0; dk < 5; ++dk) {
                    const LAS float* lp = lutl + lh * LUTP + 32 + 128 - 32 * dk + r - 4 * h;
#pragma unroll
                    for (int i = 0; i < 16; ++i) X[dk][i] = lp[-((i & 3) + 8 * (i >> 2))];
                }
#pragma unroll
                for (int s = 0; s < 4; ++s) {
                    bf16x8 kf[5];
#pragma unroll
                    for (int dk = 0; dk < 5; ++dk) { const int kt = rt + dk; const int lrow = (((b - 1 + (kt >> 2)) & 1) << 7) + ((kt & 3) << 5);
                        kf[dk] = *(const LAS bf16x8*)(Ks + (lrow + r) * 144 + 16 * h + 32 * s); }
#pragma unroll
                    for (int dk = 0; dk < 5; ++dk) X[dk] = __builtin_amdgcn_mfma_f32_32x32x16_bf16(kf[dk], qf[s], X[dk], 0, 0, 0);
                }
            } else {
#pragma unroll
            for (int dk = 0; dk < 5; ++dk) {
                if (dk >= dk_start) {
                    const int kt = rt + dk;
                    const int lrow = (((b - 1 + (kt >> 2)) & 1) << 7) + ((kt & 3) << 5);
                    const LAS unsigned char* kp = Ks + (lrow + r) * 144 + 16 * h;
                    const LAS float* lp = lutl + lh * LUTP + 32 + 128 - 32 * dk + r - 4 * h;
                    f32x16 x;
#pragma unroll
                    for (int i = 0; i < 16; ++i) x[i] = lp[-((i & 3) + 8 * (i >> 2))];
                    bf16x8 kf[4];
#pragma unroll
                    for (int s = 0; s < 4; ++s) kf[s] = *(const LAS bf16x8*)(kp + 32 * s);
#pragma unroll
                    for (int s = 0; s < 4; ++s) x = __builtin_amdgcn_mfma_f32_32x32x16_bf16(kf[s], qf[s], x, 0, 0, 0);
                    X[dk] = x;
                } else {
#pragma unroll
                    for (int i = 0; i < 16; ++i) X[dk][i] = NEGBIG;
                }
            }
            }
            float mxp[4] = {NEGBIG, NEGBIG, NEGBIG, NEGBIG};
#pragma unroll
            for (int dk = 0; dk < 5; ++dk)
#pragma unroll
                for (int i = 0; i < 16; ++i) mxp[i & 3] = fmaxf(mxp[i & 3], X[dk][i]);
            float mx = fmaxf(fmaxf(mxp[0], mxp[1]), fmaxf(mxp[2], mxp[3]));
            mx = fmaxf(mx, __shfl_xor(mx, 32));
            mx = fmaxf(mx, sink);
            float lp4[4] = {0.f, 0.f, 0.f, 0.f};
#pragma unroll
            for (int dk = 0; dk < 5; ++dk)
#pragma unroll
                for (int i = 0; i < 16; ++i) { const float p = __builtin_amdgcn_exp2f(X[dk][i] - mx); X[dk][i] = p; lp4[i & 3] += p; }
            float l = (lp4[0] + lp4[1]) + (lp4[2] + lp4[3]);
            l += __shfl_xor(l, 32);
            if (isB) l += __builtin_amdgcn_exp2f(sink - mx);
            f32x16 O[2];
#pragma unroll
            for (int i = 0; i < 16; ++i) { O[0][i] = 0.f; O[1][i] = 0.f; }
            const int i16 = lane & 15, tq = i16 >> 2, tp = i16 & 3;
            const LAS unsigned char* vbase = Vs + (4 * h + tq) * 144 + 32 * ((lane >> 4) & 1) + 8 * tp;
#pragma unroll
            for (int dk = 0; dk < 5; ++dk) {
                if (dk >= dk_start) {
                    const int kt = rt + dk;
                    const int lrow = (((b - 1 + (kt >> 2)) & 1) << 7) + ((kt & 3) << 5);
#pragma unroll
                    for (int s = 0; s < 2; ++s) {
                        u32x4 pw; pw.x = pk2(X[dk][8 * s + 0], X[dk][8 * s + 1]); pw.y = pk2(X[dk][8 * s + 2], X[dk][8 * s + 3]); pw.z = pk2(X[dk][8 * s + 4], X[dk][8 * s + 5]); pw.w = pk2(X[dk][8 * s + 6], X[dk][8 * s + 7]);
                        const bf16x8 pf = __builtin_bit_cast(bf16x8, pw);
#pragma unroll
                        for (int dt = 0; dt < 2; ++dt) {
                            const LAS unsigned char* va = vbase + (lrow + 16 * s) * 144 + 64 * dt;
                            const s16x4 lo = __builtin_amdgcn_ds_read_tr16_b64_v4i16((LAS s16x4*)(va));
                            const s16x4 hi = __builtin_amdgcn_ds_read_tr16_b64_v4i16((LAS s16x4*)(va + 8 * 144));
                            const bf16x8 vf = __builtin_shufflevector(lo, hi, 0, 1, 2, 3, 4, 5, 6, 7);
                            O[dt] = __builtin_amdgcn_mfma_f32_32x32x16_bf16(vf, pf, O[dt], 0, 0, 0);
                        }
                    }
                }
            }
            const float inv = 1.0f / l;
            bf16_t* op = qbase + qtok * qld;
#pragma unroll
            for (int dt = 0; dt < 2; ++dt)
#pragma unroll
                for (int pr = 0; pr < 2; ++pr) {
                    const int ga = 2 * pr, gb = 2 * pr + 1;
                    const unsigned x0 = pk2(O[dt][4 * ga] * inv, O[dt][4 * ga + 1] * inv), x1 = pk2(O[dt][4 * ga + 2] * inv, O[dt][4 * ga + 3] * inv);
                    const unsigned y0 = pk2(O[dt][4 * gb] * inv, O[dt][4 * gb + 1] * inv), y1 = pk2(O[dt][4 * gb + 2] * inv, O[dt][4 * gb + 3] * inv);
                    const u32x2 s0 = __builtin_amdgcn_permlane32_swap(x0, y0, false, false), s1 = __builtin_amdgcn_permlane32_swap(x1, y1, false, false);
                    u32x4 w; w.x = s0.x; w.y = s1.x; w.z = s0.y; w.w = s1.y;
                    if (isB) *(u32x4*)(YAB + tiled_off((int)qtok, 256 + qcol + 32 * dt + 8 * (2 * pr + h), 12)) = w;
                    else *(u32x4*)(op + 32 * dt + 8 * (2 * pr + h)) = w;
                }
            if (!isB && h == 0) LSE[((size_t)gi * MTOK + qtok) * 4 + 2 * hp + slot] = mx + __builtin_amdgcn_logf(l);
        }
        }
    }
}

__device__ __forceinline__ void combine_phase(const bf16_t* Z, const float* LSE, bf16_t* YAB, int gtid, int nth) {
    for (int idx = gtid; idx < MTOK * 32; idx += nth) {
        const int tok = idx >> 5; const int c = (int)(idx & 31), s = c >> 3, e0 = (c & 7) * 8;
        const float l0 = LSE[((size_t)0 * MTOK + tok) * 4 + s], l1 = LSE[((size_t)1 * MTOK + tok) * 4 + s], l2 = LSE[((size_t)2 * MTOK + tok) * 4 + s];
        const float mx = fmaxf(l0, fmaxf(l1, l2));
        const float w0 = __builtin_amdgcn_exp2f(l0 - mx), w1 = __builtin_amdgcn_exp2f(l1 - mx), w2 = __builtin_amdgcn_exp2f(l2 - mx);
        const float inv = 1.0f / (w0 + w1 + w2);
        const float a0 = w0 * inv, a1 = w1 * inv, a2 = w2 * inv;
        const bf16_t* zr = Z + ZO_QA + (size_t)tok * 768 + s * 64 + e0;
        const u32x4 o0 = *(const u32x4*)(zr), o1 = *(const u32x4*)(zr + 256), o2 = *(const u32x4*)(zr + 512);
        u32x4 w;
#pragma unroll
        for (int q = 0; q < 4; ++q) {
            const float lo = a0 * bf_lo(o0[q]) + a1 * bf_lo(o1[q]) + a2 * bf_lo(o2[q]);
            const float hi = a0 * bf_hi(o0[q]) + a1 * bf_hi(o1[q]) + a2 * bf_hi(o2[q]);
            w[q] = pk2(lo, hi);
        }
        *(u32x4*)(YAB + tiled_off(tok, s * 64 + e0, 12)) = w;
    }
}

#ifndef DBG_A
#define DBG_A -1
#endif
#ifndef DBG_B
#define DBG_B -1
#endif
#ifndef DBG_DOUBLE
#define DBG_DOUBLE -1
#endif
#ifndef DBG_GEMM_PHASE
#define DBG_GEMM_PHASE -1
#endif
#define GDBG(k) ((DBG_GEMM_PHASE == (k)) ? (unsigned long long*)(p.ws + MiB) + 20 : (unsigned long long*)nullptr)
#define REP(k) for (int rep_ = 0; rep_ < ((DBG_DOUBLE == (k)) ? 2 : 1); ++rep_)
#define TSTAMP(k) do { if (DBG_A >= 0 && wg == 0 && threadIdx.x == 0) { ((unsigned long long*)(p.ws + MiB))[k] = __builtin_amdgcn_s_memrealtime(); ((unsigned long long*)(p.ws + MiB))[32 + k] = __builtin_amdgcn_s_memtime(); } } while (0)
#ifndef PHASE_MASK
#define PHASE_MASK 0xFFFFu
#endif
#define PH(k) ((PHASE_MASK >> (k)) & 1u)

__global__ void __launch_bounds__(512, 2) fwd_kernel(Params p) {
    extern __shared__ __attribute__((aligned(16))) unsigned char lds_raw[];
    LAS unsigned char* lds = (LAS unsigned char*)lds_raw;
    cg::grid_group grid = cg::this_grid();
    const int G = gridDim.x, wg = blockIdx.x, ngw = G * 8;
    if (threadIdx.x < 16) ((LAS unsigned*)(lds + LDS_CTL_OFF))[threadIdx.x] = 0u;
    __syncthreads();
    const XcdBarrier xbar = xcd_barrier_post((unsigned*)p.ws, (volatile LAS unsigned*)(lds + LDS_CTL_OFF));
#define PHASE_IDS const int tid = otid(), lane = tid & 63, wave = __builtin_amdgcn_readfirstlane(tid >> 6), gw = wg * 8 + wave; (void)lane; (void)gw;
#define Wgu1 ((bf16_t*)(p.ws + WS_WGU1))
#define Wd1 ((bf16_t*)(p.ws + WS_WD1))
#define Win ((bf16_t*)(p.ws + WS_WIN))
#define Wbr ((bf16_t*)(p.ws + WS_WBR))
#define Wout ((bf16_t*)(p.ws + WS_WOUT))
#define Wgu2 ((bf16_t*)(p.ws + WS_WGU2))
#define Wd2 ((bf16_t*)(p.ws + WS_WD2))
#define lutg ((float*)(p.ws + WS_LUT))
#define LSE ((float*)(p.ws + WS_LSE))
#define XN ((bf16_t*)(p.ws + WS_XN))
#define HB ((bf16_t*)(p.ws + WS_HB))
#define RS ((float*)(p.ws + WS_RS))
#define SSQ ((float*)(p.ws + WS_SSQ))
#define YAB ((bf16_t*)(p.ws + WS_XN))
#define Z ((bf16_t*)(p.ws + WS_Z))
#define HID ((bf16_t*)(p.ws + WS_Z))

    TSTAMP(0);
#ifdef DBG_XCC
    if (wg == 0 && threadIdx.x == 0) *((unsigned*)(p.ws + MiB + 4096)) = 0u;
#endif
    REP(0) if (PH(0)) {
        PHASE_IDS
        LAS float* scr = (LAS float*)(lds + wave * 16384);
        constexpr int I_GU = 16 * 88, I_DN = 44 * 32, I_IN = 16 * 160, I_BA = 4 * 32, I_BB = 8 * 32, I_OUT = 16 * 32;
        constexpr int NITEMS = 6 * I_GU + I_IN + I_BA + I_BB + I_OUT;
        for (int it = gw; it < NITEMS; it += ngw) {
            int rr = it;
            bool done = false;
#pragma unroll
            for (int f = 0; f < 4; ++f) {
                if (!done && rr < I_GU) { const int kb = rr / 88, nb = rr % 88, n0 = nb * 32; const int which = f & 1, layer = f >> 1;
                    const float* W = p.in[layer ? (which ? 15 : 14) : (which ? 3 : 2)]; const float* gain = p.in[layer ? 13 : 1];
                    transpose_item(W, DFF, gain, layer ? Wgu2 : Wgu1, DM, 0, (n0 / 128) * 256 + which * 128 + (n0 % 128), kb * 64, n0, scr, lane); done = true; }
                if (!done) rr -= I_GU;
            }
            if (done) continue;
            if (rr < I_DN) { transpose_item(p.in[4], DM, nullptr, Wd1, DFF, 0, (rr % 32) * 32, (rr / 32) * 64, (rr % 32) * 32, scr, lane); continue; } rr -= I_DN;
            if (rr < I_DN) { transpose_item(p.in[16], DM, nullptr, Wd2, DFF, 0, (rr % 32) * 32, (rr / 32) * 64, (rr % 32) * 32, scr, lane); continue; } rr -= I_DN;
            if (rr < I_IN) { transpose_item(p.in[6], DIN, p.in[5], Win, DM, 0, (rr % 160) * 32, (rr / 160) * 64, (rr % 160) * 32, scr, lane); continue; } rr -= I_IN;
            if (rr < I_BA) { transpose_item(p.in[8], DM, nullptr, Wbr, 768, 0, (rr % 32) * 32, (rr / 32) * 64, (rr % 32) * 32, scr, lane); continue; } rr -= I_BA;
            if (rr < I_BB) { transpose_item(p.in[9], DM, nullptr, Wbr, 768, 256, (rr % 32) * 32, (rr / 32) * 64, (rr % 32) * 32, scr, lane); continue; } rr -= I_BB;
            transpose_item(p.in[10], DM, nullptr, Wout, DM, 0, (rr % 32) * 32, (rr / 32) * 64, (rr % 32) * 32, scr, lane);
        }
        if (wg == 0) {
            const float* rel = p.in[12];
            for (int idx = tid; idx < 20 * LUTP; idx += 512) {
                const int hd = idx / LUTP, dist = idx % LUTP - 32;
                const int dil = (hd < 4) ? 1 : ((hd < 8) ? 4 : ((hd < 12) ? 16 : 1));
                const int maxs = (hd < 12) ? 128 : 127;
                float v = NEGBIG;
                if (dist >= 0 && dist <= maxs) {
                    const int n = dist * dil; int bucket;
                    if (n < 16) bucket = n;
                    else { const float nf = (float)n; int lg = 16 + (int)(logf(nf / 16.0f) / 4.852030263919617f * 16.0f); bucket = lg < 31 ? lg : 31; }
                    v = rel[bucket * 20 + hd] * LOG2E;
                }
                lutg[idx] = v;
            }
        }
        norm_rows_bf16(p.in[0], XN, gw, ngw, lane);
    }
    if (G > (1 << 24)) grid.sync();
    xcd_barrier(xbar); TSTAMP(1);
#ifdef DBG_XCC
    if (threadIdx.x == 0) { const unsigned xcc = (unsigned)__builtin_amdgcn_s_getreg((3 << 11) | 20) & 0xFu; if (xcc != (unsigned)(wg & 7)) atomicAdd((unsigned*)(p.ws + MiB + 4096), 1u); }
#endif
    REP(1) if (PH(1)) { pg8::Gemm g{XN, Wgu1, MTOK, 2 * DFF, DM, DM, 1, GDBG(1)}; pg8::StaticOrder S; S.init(MTOK, 2 * DFF, G, wg); pg8::EpiSwiGLU E{HID, nullptr}; pg8::gemm_phase<pg8::EpiSwiGLU, (DBG_GEMM_PHASE == 1)>(lds, g, S, E); }
    xcd_barrier(xbar); TSTAMP(2);
    REP(2) if (PH(2)) { pg8::Gemm g{HID, Wd1, MTOK, DM, DFF, DFF, 1, GDBG(2)}; pg8::StaticOrder S; S.init(MTOK, DM, G, wg); pg8::EpiHB<true> E{p.in[0], HB, SSQ, 0.5f}; pg8::gemm_phase<pg8::EpiHB<true>, (DBG_GEMM_PHASE == 2)>(lds, g, S, E); }
    xcd_barrier(xbar); TSTAMP(3);
    REP(3) if (PH(3)) rowscale_phase(SSQ, RS, wg * 512 + otid(), G * 512);
    xcd_barrier(xbar); TSTAMP(4);
    REP(4) if (PH(4)) { pg8::Gemm g{HB, Win, MTOK, DIN, DM, DM, 1, GDBG(4)}; pg8::StaticOrder S; S.init(MTOK, DIN, G, wg); pg8::EpiZ E{Z, p.in[7], RS}; pg8::gemm_phase<pg8::EpiZ, (DBG_GEMM_PHASE == 4)>(lds, g, S, E); }
    xcd_barrier(xbar); TSTAMP(5);
    REP(5) if (PH(5)) attn_phase(lds, Z, YAB, LSE, lutg, p.in[11], G, wg);
    xcd_barrier(xbar); TSTAMP(6);
    REP(6) if (PH(6)) combine_phase(Z, LSE, YAB, wg * 512 + otid(), G * 512);
    xcd_barrier(xbar); TSTAMP(7);
    REP(7) if (PH(7)) { pg8::Gemm g{YAB, Wbr, MTOK, DM, 768, 768, 1, GDBG(7)}; pg8::StaticOrder S; S.init(MTOK, DM, G, wg); pg8::EpiMerge E{Z + ZO_KA, Z}; pg8::gemm_phase<pg8::EpiMerge, (DBG_GEMM_PHASE == 7)>(lds, g, S, E); }
    xcd_barrier(xbar); TSTAMP(8);
    REP(8) if (PH(8)) { pg8::Gemm g{Z + ZO_KA, Wout, MTOK, DM, DM, DM, 1, GDBG(8)}; pg8::StaticOrder S; S.init(MTOK, DM, G, wg); pg8::EpiHB<false> E{nullptr, HB, SSQ, 1.0f}; pg8::gemm_phase<pg8::EpiHB<false>, (DBG_GEMM_PHASE == 8)>(lds, g, S, E); }
    xcd_barrier(xbar); TSTAMP(9);
    REP(9) if (PH(9)) rowscale_phase(SSQ, RS, wg * 512 + otid(), G * 512);
    xcd_barrier(xbar); TSTAMP(10);
    REP(10) if (PH(10)) { pg8::Gemm g{HB, Wgu2, MTOK, 2 * DFF, DM, DM, 1, GDBG(10)}; pg8::StaticOrder S; S.init(MTOK, 2 * DFF, G, wg); pg8::EpiSwiGLU E{HID, RS}; pg8::gemm_phase<pg8::EpiSwiGLU, (DBG_GEMM_PHASE == 10)>(lds, g, S, E); }
    xcd_barrier(xbar); TSTAMP(11);
    REP(11) if (PH(11)) { pg8::Gemm g{HID, Wd2, MTOK, DM, DFF, DFF, 1, GDBG(11)}; pg8::StaticOrder S; S.init(MTOK, DM, G, wg); pg8::EpiHB<false> E{nullptr, HB, SSQ, 0.5f}; pg8::gemm_phase<pg8::EpiHB<false>, (DBG_GEMM_PHASE == 11)>(lds, g, S, E); }
    xcd_barrier(xbar); TSTAMP(12);
    REP(12) if (PH(12)) {
        PHASE_IDS
        const float* gf = p.in[17];
        const f32x4 g0 = *((const f32x4*)gf + 4 * lane), g1 = *((const f32x4*)gf + 4 * lane + 1), g2 = *((const f32x4*)gf + 4 * lane + 2), g3 = *((const f32x4*)gf + 4 * lane + 3);
        for (int m = 2 * gw; m < MTOK; m += 2 * ngw) {
            u32x4 hv[2][2]; float ps[2];
#pragma unroll
            for (int q = 0; q < 2; ++q) { const u32x4* hr = (const u32x4*)(HB + tiled_off(m + q, 16 * lane, DM / 64)); hv[q][0] = hr[0]; hv[q][1] = hr[1]; ps[q] = SSQ[(size_t)(m + q) * 16 + (lane & 15)]; }
#pragma unroll
            for (int q = 0; q < 2; ++q) {
                float sum = ps[q];
#pragma unroll
                for (int o = 1; o < 16; o <<= 1) sum += __shfl_xor(sum, o);
                const float r = 1.0f / sqrtf(sum * (1.0f / DM) + EPS);
                f32x4* orow = (f32x4*)(p.out + (size_t)(m + q) * DM) + 4 * lane;
                const u32x4 a = hv[q][0], b = hv[q][1];
                orow[0] = (f32x4){bf_lo(a.x), bf_hi(a.x), bf_lo(a.y), bf_hi(a.y)} * r * g0;
                orow[1] = (f32x4){bf_lo(a.z), bf_hi(a.z), bf_lo(a.w), bf_hi(a.w)} * r * g1;
                orow[2] = (f32x4){bf_lo(b.x), bf_hi(b.x), bf_lo(b.y), bf_hi(b.y)} * r * g2;
                orow[3] = (f32x4){bf_lo(b.z), bf_hi(b.z), bf_lo(b.w), bf_hi(b.w)} * r * g3;
            }
        }
    }
    if (DBG_A >= 0) {
        grid.sync();
        if (wg == 0) { const unsigned long long* tsp = (const unsigned long long*)(p.ws + MiB);
#ifdef DBG_XCC
            const long n = 100 + 10 * (long)(*((const unsigned*)(p.ws + MiB + 4096)));
#else
#ifdef DBG_CLOCK
            const long n = (long)((tsp[32 + DBG_B] - tsp[32 + DBG_A]) * 100 / (tsp[DBG_B] - tsp[DBG_A]));
#else
            const long n = DBG_GEMM_MODE ? (long)(tsp[20] / 10) : (long)(tsp[DBG_B >= 0 ? DBG_B : 0] - tsp[DBG_A >= 0 ? DBG_A : 0]) / 10;
#endif
#endif

            for (long i = threadIdx.x; i < n; i += 512) p.out[(size_t)i * 997 + 3] += 0.1f; }
    }
}

#undef Z
#undef XN
#undef HB
#undef RS
#undef SSQ
#undef YAB
#undef HID
#undef LSE
#undef lutg
extern "C" void kernel_launch(void* const* d_in, const int* in_sizes, int n_in, void* d_out, int out_size, void* d_ws, size_t ws_size, hipStream_t stream) {
    static int grid = 0;
    if (grid == 0) {
        if (n_in != 18 || out_size != MTOK * DM || ws_size < WS_END) { fprintf(stderr, "kernel_launch: unexpected shapes (n_in %d out %d ws %zu)\n", n_in, out_size, ws_size); grid = -1; return; }
        int dev = 0, cus = 0, per_cu = 0;
        if (hipGetDevice(&dev) != hipSuccess || hipDeviceGetAttribute(&cus, hipDeviceAttributeMultiprocessorCount, dev) != hipSuccess) { grid = -1; return; }
        if (hipFuncSetAttribute((const void*)fwd_kernel, hipFuncAttributeMaxDynamicSharedMemorySize, LDS_BYTES) != hipSuccess) { fprintf(stderr, "hipFuncSetAttribute failed\n"); grid = -1; return; }
        if (hipOccupancyMaxActiveBlocksPerMultiprocessor(&per_cu, (const void*)fwd_kernel, 512, LDS_BYTES) != hipSuccess || per_cu < 1) per_cu = 1;
        (void)hipGetLastError();
        grid = cus * per_cu;
    }
    if (grid < 0) return;
    if (hipMemsetAsync(d_ws, 0, XCD_BAR_WORDS * 4, stream) != hipSuccess) { fprintf(stderr, "memset failed\n"); return; }
    Params p{};
    for (int i = 0; i < 18; ++i) p.in[i] = (const float*)d_in[i];
    p.out = (float*)d_out; p.ws = (unsigned char*)d_ws;
    void* args[] = {&p};
    hipError_t e = hipLaunchCooperativeKernel((const void*)fwd_kernel, dim3(grid), dim3(512), args, LDS_BYTES, stream);
    if (e != hipSuccess) fprintf(stderr, "cooperative launch failed: %s (grid %d)\n", hipGetErrorString(e), grid);
}
```

```cpp
#include <hip/hip_runtime.h>
#include <hip/hip_cooperative_groups.h>
#include <cstdio>
namespace cg = cooperative_groups;

#define LAS __attribute__((address_space(3)))
typedef unsigned short bf16_t;
typedef short bf16x8 __attribute__((ext_vector_type(8)));
typedef short s16x4 __attribute__((ext_vector_type(4)));
typedef float f32x4 __attribute__((ext_vector_type(4)));
typedef float f32x2 __attribute__((ext_vector_type(2)));
typedef float f32x16 __attribute__((ext_vector_type(16)));
typedef unsigned u32x4 __attribute__((ext_vector_type(4)));
typedef unsigned u32x2 __attribute__((ext_vector_type(2)));
typedef __bf16 bf16x2v __attribute__((ext_vector_type(2)));

constexpr int MTOK = 65536, DM = 1024, DFF = 2816, DIN = 5120, SEQ = 2048;
constexpr float EPS = 1e-6f, LOG2E = 1.4426950408889634f, QSCALE = 0.125f * 1.4426950408889634f, NEGBIG = -1e30f;
constexpr int ZAQ = 0, ZAK = 768, ZAV = 1536, ZBQ = 2304, ZBK = 2816, ZBV = 2944, ZGA = 3072, ZGB = 4096;
constexpr size_t ZO_KA = 0, ZO_VA = (size_t)MTOK * 768, ZO_QA = (size_t)MTOK * 1536, ZO_QB = (size_t)MTOK * 2304, ZO_KVB = (size_t)MTOK * 2816, ZO_G = (size_t)MTOK * 3072;
constexpr int LUTP = 192;
constexpr int LDS_CTL_OFF = 147456 + 8 * LUTP * 4;
constexpr int LDS_BYTES = LDS_CTL_OFF + 64;

constexpr size_t MiB = 1u << 20;
constexpr size_t WS_WGU1 = 2 * MiB, WS_WD1 = 14 * MiB, WS_WIN = 20 * MiB, WS_WBR = 30 * MiB, WS_WOUT = 32 * MiB, WS_WGU2 = 34 * MiB, WS_WD2 = 46 * MiB;
constexpr size_t WS_LUT = 52 * MiB, WS_LSE = 53 * MiB, WS_RS = 56 * MiB, WS_SSQ = 57 * MiB, WS_XN = 64 * MiB, WS_HB = 192 * MiB, WS_Z = 320 * MiB, WS_END = 960 * MiB;

__device__ __forceinline__ unsigned pk2(float lo, float hi) { f32x2 f = {lo, hi}; return __builtin_bit_cast(unsigned, __builtin_convertvector(f, bf16x2v)); }
__device__ __forceinline__ float bf_lo(unsigned u) { return __uint_as_float(u << 16); }
__device__ __forceinline__ float bf_hi(unsigned u) { return __uint_as_float(u & 0xffff0000u); }
__device__ __forceinline__ float fast_sigmoid(float v) { return __builtin_amdgcn_rcpf(1.0f + __builtin_amdgcn_exp2f(-v * LOG2E)); }

__device__ __forceinline__ size_t tiled_off(int row, int col, int ktiles) {
    const int r = row & 127, c = col & 63;
    const int st = (r >> 4) * 2 + (c >> 5), ob = (r & 15) * 64 + (c & 31) * 2;
    const int byte = st * 1024 + (ob ^ (((ob >> 9) & 1) << 5));
    return ((size_t)(((row >> 8) * ktiles + (col >> 6)) * 2 + ((row >> 7) & 1))) * 8192 + (byte >> 1);
}
__device__ __forceinline__ int wslot(int x) { return (x & ~31) | ((((x >> 2) & 1) << 4) | (((x >> 3) & 3) << 2) | (x & 3)); }
__device__ __forceinline__ const char* uni_ptr(const char* p) { const unsigned long long v = (unsigned long long)p; const unsigned lo = __builtin_amdgcn_readfirstlane((unsigned)v), hi = __builtin_amdgcn_readfirstlane((unsigned)(v >> 32)); return (const char*)(((unsigned long long)hi << 32) | lo); }
namespace pg8 {
constexpr int BM = 256, BK = 64, HALF = 128, HTB = HALF * BK * 2, STAGE_BYTES = 8 * HTB, NXCD = 8, WGM = 8;
__host__ __device__ __forceinline__ int lds_byte(int r, int c) { const int st = (r >> 4) * 2 + (c >> 5), rr = r & 15, cc = c & 31, ob = rr * 64 + cc * 2; return st * 1024 + (ob ^ (((ob >> 9) & 1) << 5)); }
__host__ __device__ __forceinline__ void stage_rc(int b, int& R, int& C) { const int st = b / 1024, sb = b % 1024, swz = sb ^ (((sb >> 9) & 1) << 5); R = (st >> 1) * 16 + swz / 64; C = (st & 1) * 32 + (swz % 64) / 2; }
__host__ __device__ __forceinline__ int perm32(int rho) { const int n = rho >> 4, i = rho & 15; return 8 * (i >> 2) + 4 * n + (i & 3); }
struct Unit { int pm, pn; };
struct Gemm { const bf16_t* A; const bf16_t* Bt; int M, N, K; int lda; int a_tiled; unsigned long long* dbg; };
struct StaticOrder {
    int nM, nN, nwg, G, c;
    __device__ void init(int M, int N, int G_, int c_) { nM = M / BM; nN = N / BM; nwg = nM * nN; G = G_; c = c_; }
    __device__ bool next(int i, Unit& u) const {
        const long L = (long)i * G + c; if (L >= nwg) return false;
        int wgid = (int)L; { const int q = nwg / NXCD, r = nwg % NXCD, xcd = wgid % NXCD, off = wgid / NXCD; wgid = (xcd < r ? xcd * (q + 1) : r * (q + 1) + (xcd - r) * q) + off; }
        const int nig = WGM * nN, gid = wgid / nig, fm = gid * WGM, gsz = (nM - fm) < WGM ? (nM - fm) : WGM;
        u.pm = fm + ((wgid % nig) % gsz); u.pn = (wgid % nig) / gsz; return true;
    }
};

typedef f32x4 Acc[2][2][4][2];

struct EpiSwiGLU {
    static constexpr bool PERM = true; static constexpr int MID_T = -1;
    bf16_t* O; const float* rs;
    __device__ __forceinline__ void mid(Acc&, const Unit&, int, int, int, int) const {}
    __device__ __forceinline__ void operator()(const Acc& acc, const Unit& u, int wr, int wc, int fr, int fq) const {
        int opq; asm volatile("v_mov_b32 %0, 0" : "=v"(opq));
        const int row0 = u.pm * BM + wr * 64 + fr + opq;
        float rsv[2][4];
#pragma unroll
        for (int ai = 0; ai < 2; ++ai)
#pragma unroll
            for (int m = 0; m < 4; ++m) rsv[ai][m] = rs ? rs[row0 + ai * HALF + m * 16] : 1.0f;
#pragma unroll
        for (int ai = 0; ai < 2; ++ai)
#pragma unroll
            for (int m = 0; m < 4; ++m) {
                bf16_t* rowp = O + tiled_off(row0 + ai * HALF + m * 16, u.pn * 128 + wc * 32 + 8 * fq, DFF / 64);
                float hv[8];
#pragma unroll
                for (int n = 0; n < 2; ++n)
#pragma unroll
                    for (int j = 0; j < 4; ++j) { const float g = acc[ai][0][m][n][j] * rsv[ai][m], up = acc[ai][1][m][n][j] * rsv[ai][m]; hv[4 * n + j] = g * fast_sigmoid(g) * up; }
                u32x4 w; w.x = pk2(hv[0], hv[1]); w.y = pk2(hv[2], hv[3]); w.z = pk2(hv[4], hv[5]); w.w = pk2(hv[6], hv[7]);
                *(u32x4*)rowp = w;
            }
    }
};
template <bool BASE_F32> struct EpiHB {
    static constexpr bool PERM = true; static constexpr int MID_T = -1;
    const float* xbase; bf16_t* hb; float* ssq; float scale;
    __device__ __forceinline__ void mid(Acc&, const Unit&, int, int, int, int) const {}
    __device__ __forceinline__ void operator()(const Acc& acc, const Unit& u, int wr, int wc, int fr, int fq) const {
        int opq; asm volatile("v_mov_b32 %0, 0" : "=v"(opq));
        const int row0 = u.pm * BM + wr * 64 + fr + opq, col0 = u.pn * BM + wc * 32 + 8 * fq;
#pragma unroll
        for (int ai = 0; ai < 2; ++ai) {
            f32x4 bx[BASE_F32 ? 4 : 1][2][2]; u32x4 bh[BASE_F32 ? 1 : 4][2];
#pragma unroll
            for (int m = 0; m < 4; ++m) {
                const size_t off = (size_t)(row0 + ai * HALF + m * 16) * DM + col0;
#pragma unroll
                for (int bj = 0; bj < 2; ++bj) {
                    if constexpr (BASE_F32) { bx[m][bj][0] = *(const f32x4*)(xbase + off + bj * HALF); bx[m][bj][1] = *(const f32x4*)(xbase + off + bj * HALF + 4); }
                    else bh[m][bj] = *(const u32x4*)(hb + tiled_off(row0 + ai * HALF + m * 16, col0 + bj * HALF, DM / 64));
                }
            }
            asm volatile("" ::: "memory");
#pragma unroll
            for (int m = 0; m < 4; ++m) {
                const size_t off = (size_t)(row0 + ai * HALF + m * 16) * DM + col0;
                float sq = 0.f;
#pragma unroll
                for (int bj = 0; bj < 2; ++bj) {
                    f32x4 v0, v1;
                    if constexpr (BASE_F32) { v0 = bx[m][bj][0]; v1 = bx[m][bj][1]; }
                    else { const u32x4 b = bh[m][bj]; v0 = (f32x4){bf_lo(b.x), bf_hi(b.x), bf_lo(b.y), bf_hi(b.y)}; v1 = (f32x4){bf_lo(b.z), bf_hi(b.z), bf_lo(b.w), bf_hi(b.w)}; }
                    v0 += acc[ai][bj][m][0] * scale; v1 += acc[ai][bj][m][1] * scale;
                    sq += (v0[0] * v0[0] + v0[1] * v0[1]) + (v0[2] * v0[2] + v0[3] * v0[3]) + (v1[0] * v1[0] + v1[1] * v1[1]) + (v1[2] * v1[2] + v1[3] * v1[3]);
                    u32x4 w; w.x = pk2(v0[0], v0[1]); w.y = pk2(v0[2], v0[3]); w.z = pk2(v1[0], v1[1]); w.w = pk2(v1[2], v1[3]);
                    *(u32x4*)(hb + tiled_off(row0 + ai * HALF + m * 16, col0 + bj * HALF, DM / 64)) = w;
                }
                sq += __shfl_xor(sq, 16); sq += __shfl_xor(sq, 32);
                if (fq == 0) ssq[(size_t)(row0 + ai * HALF + m * 16) * 16 + u.pn * 4 + wc] = sq;
            }
            asm volatile("" ::: "memory");
        }
    }
};
struct EpiZ {
    static constexpr bool PERM = true; static constexpr int MID_T = -1;
    bf16_t* O; const float* bias; const float* rs;
    __device__ __forceinline__ void mid(Acc&, const Unit&, int, int, int, int) const {}
    __device__ __forceinline__ void operator()(const Acc& acc, const Unit& u, int wr, int wc, int fr, int fq) const {
        int opq; asm volatile("v_mov_b32 %0, 0" : "=v"(opq));
        const int row0 = u.pm * BM + wr * 64 + fr + opq, col0 = u.pn * BM + wc * 32 + 8 * fq;
        float rsv[2][4];
#pragma unroll
        for (int ai = 0; ai < 2; ++ai)
#pragma unroll
            for (int m = 0; m < 4; ++m) rsv[ai][m] = rs[row0 + ai * HALF + m * 16];
        const bool isq = (u.pn < 3) || (u.pn == 9) || (u.pn == 10), isg = (u.pn >= 12);
        const int pn = u.pn; size_t bo; int ld, c0;
        if (pn < 3) { bo = ZO_QA; ld = 768; c0 = pn * 256; } else if (pn < 6) { bo = ZO_KA; ld = 768; c0 = (pn - 3) * 256; } else if (pn < 9) { bo = ZO_VA; ld = 768; c0 = (pn - 6) * 256; }
        else if (pn < 11) { bo = ZO_QB; ld = 512; c0 = (pn - 9) * 256; } else if (pn == 11) { bo = ZO_KVB; ld = 256; c0 = 0; } else { bo = ZO_G; ld = 2048; c0 = (pn - 12) * 256; }
        bf16_t* blk = O + bo; const int cb = c0 + wc * 32 + 8 * fq;
        const float sc = isq ? QSCALE : 1.0f;
        f32x4 bv[2][2];
#pragma unroll
        for (int bj = 0; bj < 2; ++bj)
#pragma unroll
            for (int n = 0; n < 2; ++n) bv[bj][n] = *(const f32x4*)(bias + col0 + bj * HALF + 4 * n);
#pragma unroll
        for (int ai = 0; ai < 2; ++ai)
#pragma unroll
            for (int m = 0; m < 4; ++m) {
                bf16_t* rowp = blk + (size_t)(row0 + ai * HALF + m * 16) * ld + cb;
#pragma unroll
                for (int bj = 0; bj < 2; ++bj) {
                    f32x4 v0 = (acc[ai][bj][m][0] * rsv[ai][m] + bv[bj][0]) * sc, v1 = (acc[ai][bj][m][1] * rsv[ai][m] + bv[bj][1]) * sc;
                    if (isg) {
#pragma unroll
                        for (int j = 0; j < 4; ++j) { v0[j] = fast_sigmoid(v0[j]); v1[j] = fast_sigmoid(v1[j]); }
                    }
                    u32x4 w; w.x = pk2(v0[0], v0[1]); w.y = pk2(v0[2], v0[3]); w.z = pk2(v1[0], v1[1]); w.w = pk2(v1[2], v1[3]);
                    *(u32x4*)(rowp + bj * HALF) = w;
                }
            }
    }
};
struct EpiMerge {
    static constexpr bool PERM = true; static constexpr int MID_T = 2;
    bf16_t* O; const bf16_t* Z;
    __device__ __forceinline__ void mid(Acc& acc, const Unit& u, int wr, int wc, int fr, int fq) const {
        int opq; asm volatile("v_mov_b32 %0, 0" : "=v"(opq));
        const int row0 = u.pm * BM + wr * 64 + fr + opq, col0 = u.pn * BM + wc * 32 + 8 * fq;
#pragma unroll
        for (int ai = 0; ai < 2; ++ai) {
            u32x4 sa[4][2], sb[4][2];
#pragma unroll
            for (int m = 0; m < 4; ++m) {
                const bf16_t* zr = Z + ZO_G + (size_t)(row0 + ai * HALF + m * 16) * 2048 + col0;
#pragma unroll
                for (int bj = 0; bj < 2; ++bj) { sa[m][bj] = *(const u32x4*)(zr + bj * HALF); sb[m][bj] = *(const u32x4*)(zr + 1024 + bj * HALF); }
            }
            asm volatile("" ::: "memory");
#pragma unroll
            for (int m = 0; m < 4; ++m)
#pragma unroll
                for (int bj = 0; bj < 2; ++bj) {
#pragma unroll
                    for (int q = 0; q < 4; ++q) {
                        const float a0 = bf_lo(sa[m][bj][q]), a1 = bf_hi(sa[m][bj][q]), b0 = fmaxf(bf_lo(sb[m][bj][q]), 1e-30f), b1 = fmaxf(bf_hi(sb[m][bj][q]), 1e-30f);
                        acc[ai][bj][m][q >> 1][(q & 1) * 2] *= a0 * __builtin_amdgcn_rcpf(b0);
                        acc[ai][bj][m][q >> 1][(q & 1) * 2 + 1] *= a1 * __builtin_amdgcn_rcpf(b1);
                    }
                }
            asm volatile("" : "+v"(acc[ai][0][0][0]), "+v"(acc[ai][1][3][1]) :: "memory");
        }
    }
    __device__ __forceinline__ void operator()(const Acc& acc, const Unit& u, int wr, int wc, int fr, int fq) const {
        const int row0 = u.pm * BM + wr * 64 + fr, col0 = u.pn * BM + wc * 32 + 8 * fq;
        u32x4 sbv[2][4][2];
#pragma unroll
        for (int ai = 0; ai < 2; ++ai)
#pragma unroll
            for (int m = 0; m < 4; ++m) {
                const bf16_t* zr = Z + ZO_G + (size_t)(row0 + ai * HALF + m * 16) * 2048 + col0;
#pragma unroll
                for (int bj = 0; bj < 2; ++bj) sbv[ai][m][bj] = *(const u32x4*)(zr + 1024 + bj * HALF);
            }
        asm volatile("" ::: "memory");
#pragma unroll
        for (int ai = 0; ai < 2; ++ai)
#pragma unroll
            for (int m = 0; m < 4; ++m) {
                const int orow = row0 + ai * HALF + m * 16;
#pragma unroll
                for (int bj = 0; bj < 2; ++bj) {
                    const u32x4 sb = sbv[ai][m][bj];
                    float o[8];
#pragma unroll
                    for (int q = 0; q < 4; ++q) {
                        o[2 * q] = acc[ai][bj][m][q >> 1][(q & 1) * 2] * fmaxf(bf_lo(sb[q]), 1e-30f);
                        o[2 * q + 1] = acc[ai][bj][m][q >> 1][(q & 1) * 2 + 1] * fmaxf(bf_hi(sb[q]), 1e-30f);
                    }
                    u32x4 w; w.x = pk2(o[0], o[1]); w.y = pk2(o[2], o[3]); w.z = pk2(o[4], o[5]); w.w = pk2(o[6], o[7]);
                    *(u32x4*)(O + tiled_off(orow, col0 + bj * HALF, DM / 64)) = w;
                }
            }
    }
};

template <class Epi, bool DBGP = false>
__device__ __forceinline__ void gemm_phase(LAS unsigned char* lds, const Gemm g, const StaticOrder& S, const Epi& E) {
    int tid_o = threadIdx.x; asm volatile("" : "+v"(tid_o));
    const int tid = tid_o, wid = __builtin_amdgcn_readfirstlane(tid >> 6), lane = tid & 63, wr = wid >> 2, wc = wid & 3, fr = lane & 15, fq = lane >> 4;
    const int K = g.K, nt = K / BK;
    unsigned voffA[2], voffB[2];
#pragma unroll
    for (int i = 0; i < 2; ++i) { int R, C; stage_rc(tid * 16 + i * 8192, R, C); const int Rb = Epi::PERM ? ((R & ~31) + perm32(R & 31)) : R;
        (void)Rb; voffA[i] = g.a_tiled ? (unsigned)(tid * 16 + i * 8192) : (unsigned)(R * g.lda + C) * 2u; voffB[i] = (unsigned)(tid * 16 + i * 8192); }
    const size_t kstep = (size_t)(BM * BK * 2);
    const size_t hstep = (size_t)(HALF * BK * 2);
    const size_t tstep = (size_t)BM * K * 2;
    const size_t kstepA = g.a_tiled ? kstep : (size_t)(BK * 2), hstepA = g.a_tiled ? hstep : (size_t)HALF * g.lda * 2;
    const size_t tstepA = g.a_tiled ? tstep : 2 * hstepA;
    const unsigned ldsw = (unsigned)wid * 1024u;
    const int aoff = lds_byte(wr * 64 + fr, fq * 8), boff = lds_byte(wc * 32 + fr, fq * 8);
#define PG8_SA(b, h) (((b) * 2 + (h)) * HTB)
#define PG8_SB(b, h) ((4 + (b) * 2 + (h)) * HTB)
#define PG8_STAGE(bufoff, gbase, voff) do { _Pragma("unroll") for (int _i = 0; _i < 2; ++_i) \
        __builtin_amdgcn_global_load_lds((const unsigned*)((const char*)(gbase) + (voff)[_i]), (LAS unsigned*)(lds + (bufoff) + ldsw + _i * 8192), 16, 0, 0); } while (0)
#define PG8_LDA(dst, b, h) do { _Pragma("unroll") for (int m = 0; m < 4; ++m) _Pragma("unroll") for (int k = 0; k < 2; ++k) dst[m][k] = *(const LAS bf16x8*)(lds + PG8_SA(b, h) + aoff + m * 2048 + k * 1024); } while (0)
#define PG8_LDB(dst, b, h) do { _Pragma("unroll") for (int n = 0; n < 2; ++n) _Pragma("unroll") for (int k = 0; k < 2; ++k) dst[n][k] = *(const LAS bf16x8*)(lds + PG8_SB(b, h) + boff + n * 2048 + k * 1024); } while (0)
#define PG8_MMA(ai, bj, At, Bt) do { __builtin_amdgcn_s_setprio(1); _Pragma("unroll") for (int m = 0; m < 4; ++m) _Pragma("unroll") for (int n = 0; n < 2; ++n) _Pragma("unroll") for (int k = 0; k < 2; ++k) \
        acc[ai][bj][m][n] = __builtin_amdgcn_mfma_f32_16x16x32_bf16(Bt[n][k], At[m][k], acc[ai][bj][m][n], 0, 0, 0); __builtin_amdgcn_s_setprio(0); } while (0)
#define PG8_WAIT_V(n) asm volatile("s_waitcnt vmcnt(" #n ")" ::: "memory")
#define PG8_WAIT_L(n) asm volatile("s_waitcnt lgkmcnt(" #n ")" ::: "memory")
#define PG8_BAR __builtin_amdgcn_s_barrier()
#define PG8_SCHED __builtin_amdgcn_sched_barrier(0)
#ifndef DBG_GEMM_MODE
#define DBG_GEMM_MODE 0
#endif
    unsigned long long dbg_acc = 0, dbg_t0 = 0; (void)dbg_t0;
    Unit cur, nxt; int ui = 0;
    if (!S.next(0, cur)) return;
    Acc acc;
#pragma unroll
    for (int a = 0; a < 2; ++a)
#pragma unroll
        for (int b = 0; b < 2; ++b)
#pragma unroll
            for (int m = 0; m < 4; ++m)
#pragma unroll
                for (int n = 0; n < 2; ++n) acc[a][b][m][n] = (f32x4){0.f, 0.f, 0.f, 0.f};
    bf16x8 At[4][2], B0[2][2], B1[2][2];
    const char* cA = uni_ptr((const char*)g.A + (size_t)cur.pm * tstepA); const char* cB = uni_ptr((const char*)g.Bt + (size_t)cur.pn * tstep);
    PG8_STAGE(PG8_SB(0, 0), cB, voffB); PG8_STAGE(PG8_SB(0, 1), cB + hstep, voffB); PG8_STAGE(PG8_SA(0, 0), cA, voffA); PG8_STAGE(PG8_SA(0, 1), cA + hstepA, voffA);
    if (wr == 1) PG8_BAR;
    PG8_WAIT_V(2); PG8_BAR;
    PG8_STAGE(PG8_SB(1, 0), cB + kstep, voffB); PG8_STAGE(PG8_SA(1, 0), cA + kstepA, voffA); PG8_STAGE(PG8_SB(1, 1), cB + hstep + kstep, voffB);
    PG8_WAIT_V(6); PG8_BAR;
    for (;;) {
        const bool has_next = S.next(ui + 1, nxt);
        const char* nA = uni_ptr(has_next ? (const char*)g.A + (size_t)nxt.pm * tstepA : cA); const char* nB = uni_ptr(has_next ? (const char*)g.Bt + (size_t)nxt.pn * tstep : cB);
        if (DBG_GEMM_MODE == 3 && DBGP) dbg_t0 = __builtin_amdgcn_s_memrealtime();
        if (DBG_GEMM_MODE == 5 && DBGP && ui > 0) dbg_acc += __builtin_amdgcn_s_memrealtime() - dbg_t0;
        for (int t = 0; t < nt; t += 2) {
            if (DBG_GEMM_MODE == 2 && DBGP && t == 2) dbg_t0 = __builtin_amdgcn_s_memrealtime();
            if (DBG_GEMM_MODE == 3 && DBGP && t == 2) dbg_acc += __builtin_amdgcn_s_memrealtime() - dbg_t0;
            const bool last = (t == nt - 2);
            const char* a1 = cA + (size_t)(t + 1) * kstepA;
            const char* a2 = last ? nA : cA + (size_t)(t + 2) * kstepA; const char* b2 = last ? nB : cB + (size_t)(t + 2) * kstep;
            const char* a3 = a2 + kstepA; const char* b3 = b2 + kstep;
            PG8_LDB(B0, 0, 0); PG8_LDB(B1, 0, 1); PG8_SCHED; PG8_LDA(At, 0, 0); PG8_STAGE(PG8_SA(1, 1), a1 + hstepA, voffA);
            PG8_WAIT_V(8); PG8_WAIT_L(0); PG8_BAR; PG8_MMA(0, 0, At, B0); PG8_MMA(0, 1, At, B1); PG8_BAR; PG8_SCHED;
            PG8_LDA(At, 0, 1); PG8_STAGE(PG8_SB(0, 0), b2, voffB); PG8_STAGE(PG8_SB(0, 1), b2 + hstep, voffB); PG8_STAGE(PG8_SA(0, 0), a2, voffA);
            PG8_WAIT_V(8); PG8_WAIT_L(0); PG8_BAR; PG8_MMA(1, 0, At, B0); PG8_MMA(1, 1, At, B1); PG8_BAR; PG8_SCHED;
            PG8_LDB(B0, 1, 0); PG8_LDB(B1, 1, 1); PG8_SCHED; PG8_LDA(At, 1, 0); PG8_STAGE(PG8_SA(0, 1), a2 + hstepA, voffA);
            PG8_WAIT_V(8); PG8_WAIT_L(0); PG8_BAR; PG8_MMA(0, 0, At, B0); PG8_MMA(0, 1, At, B1); PG8_BAR; PG8_SCHED;
            PG8_LDA(At, 1, 1); PG8_STAGE(PG8_SB(1, 0), b3, voffB); PG8_STAGE(PG8_SB(1, 1), b3 + hstep, voffB); PG8_STAGE(PG8_SA(1, 0), a3, voffA);
            PG8_WAIT_V(8); PG8_WAIT_L(0); PG8_BAR; PG8_MMA(1, 0, At, B0); PG8_MMA(1, 1, At, B1); PG8_BAR; PG8_SCHED;
            if constexpr (Epi::MID_T >= 0) { if (t == Epi::MID_T) { E.mid(acc, cur, wr, wc, fr, fq); PG8_SCHED; } }
        }
        if (DBG_GEMM_MODE == 2 && DBGP) dbg_acc += __builtin_amdgcn_s_memrealtime() - dbg_t0;
        if (DBG_GEMM_MODE == 5 && DBGP) dbg_t0 = __builtin_amdgcn_s_memrealtime();
        if (wr == 0) PG8_BAR;
        if (DBG_GEMM_MODE == 1 && DBGP) dbg_t0 = __builtin_amdgcn_s_memrealtime();
        E(acc, cur, wr, wc, fr, fq);
#ifdef DBG_EPI2
        if (DBGP) { asm volatile("" ::: "memory"); E(acc, cur, wr, wc, fr, fq); }
#endif
        if (DBG_GEMM_MODE == 1 && DBGP) dbg_acc += __builtin_amdgcn_s_memrealtime() - dbg_t0;
        if (!has_next) break;
#pragma unroll
        for (int a = 0; a < 2; ++a)
#pragma unroll
            for (int b = 0; b < 2; ++b)
#pragma unroll
                for (int m = 0; m < 4; ++m)
#pragma unroll
                    for (int n = 0; n < 2; ++n) acc[a][b][m][n] = (f32x4){0.f, 0.f, 0.f, 0.f};
        cur = nxt; cA = nA; cB = nB; ++ui;
        if (wr == 1) PG8_BAR;
    }
    PG8_WAIT_V(0);
    PG8_BAR;
    if (DBG_GEMM_MODE && DBGP && blockIdx.x == 0 && tid == 0) *g.dbg = dbg_acc;
#undef PG8_SA
#undef PG8_SB
#undef PG8_STAGE
#undef PG8_LDA
#undef PG8_LDB
#undef PG8_MMA
#undef PG8_WAIT_V
#undef PG8_WAIT_L
#undef PG8_BAR
#undef PG8_SCHED
}
}

#define XB_TMO      128
#define XB_XCNT(j)  (256  + 64 * (j))
#define XB_XSUB(j)  (1280 + 64 * (j))
#define XB_XGEN(j)  (2304 + 64 * (j))
#define XB_TOP      3328
#define XB_TOPGEN   3392
#define XCD_BAR_WORDS 3456
#define XB_SPIN_CAP (1u << 18)

__device__ __forceinline__ unsigned xb_ld(unsigned* p)              { return __hip_atomic_load(p, __ATOMIC_RELAXED, __HIP_MEMORY_SCOPE_AGENT); }
__device__ __forceinline__ unsigned xb_add(unsigned* p, unsigned v) { return __hip_atomic_fetch_add(p, v, __ATOMIC_RELAXED, __HIP_MEMORY_SCOPE_AGENT); }
__device__ __forceinline__ unsigned xb_xcc_id() { return (unsigned)__builtin_amdgcn_s_getreg((3 << 11) | 20) & 0xFu; }
#define XB_SPIN(cond, bar) do { unsigned _sp = 0; while (cond) { __builtin_amdgcn_s_sleep(1); \
    if ((++_sp & 255u) == 0u) { if (xb_ld(&(bar)[XB_TMO])) break; if (_sp > XB_SPIN_CAP) { atomicAdd(&(bar)[XB_TMO], 1u); break; } } } } while (0)

struct XcdBarrier {
    unsigned* bar; unsigned x;
    volatile LAS unsigned* st;
};

__device__ __forceinline__ XcdBarrier xcd_barrier_post(unsigned* bar, volatile LAS unsigned* st) {
    XcdBarrier b; b.bar = bar; b.x = xb_xcc_id(); b.st = st;
    if (threadIdx.x == 0) (void)xb_add(&bar[XB_XCNT(b.x)], 1u);
    return b;
}
__device__ __forceinline__ void xcd_barrier_complete(unsigned* bar, unsigned x, unsigned& nloc, unsigned& nx) {
    const unsigned G = gridDim.x * gridDim.y * gridDim.z;
    unsigned sum, cnt, mine, sp = 0u;
    for (;;) {
        sum = 0u; cnt = 0u; mine = 0u;
#pragma unroll
        for (unsigned j = 0; j < 16; ++j) { const unsigned c = xb_ld(&bar[XB_XCNT(j)]); sum += c; cnt += (c > 0u) ? 1u : 0u; mine = (j == x) ? c : mine; }
        if (sum == G) break;
        __builtin_amdgcn_s_sleep(1);
        if ((++sp & 255u) == 0u) { if (xb_ld(&bar[XB_TMO])) break; if (sp > XB_SPIN_CAP) { atomicAdd(&bar[XB_TMO], 1u); break; } }
    }
    nloc = mine > 0u ? mine : 1u; nx = cnt > 0u ? cnt : 1u;
}

__device__ __forceinline__ void xcd_barrier(const XcdBarrier& b) {
    asm volatile("s_waitcnt vmcnt(0)" ::: "memory");
    __syncthreads();
    if (threadIdx.x == 0) {
        unsigned* bar = b.bar;
        __builtin_amdgcn_s_waitcnt(0);
        unsigned nloc = b.st[0], nx = b.st[1];
        if (nloc == 0u) { xcd_barrier_complete(bar, b.x, nloc, nx); b.st[0] = nloc; b.st[1] = nx; }
        const unsigned old = xb_add(&bar[XB_XSUB(b.x)], 1u);
        const unsigned gen = old / nloc;
        if (old + 1u == (gen + 1u) * nloc) {
            __builtin_amdgcn_fence(__ATOMIC_RELEASE, "agent");
            asm volatile("s_waitcnt vmcnt(0)" ::: "memory");
            const unsigned og = xb_add(&bar[XB_TOP], 1u);
            const unsigned tg = og / nx;
            if (og + 1u == (tg + 1u) * nx) xb_add(&bar[XB_TOPGEN], 1u);
            else XB_SPIN(xb_ld(&bar[XB_TOPGEN]) == tg, bar);
            __builtin_amdgcn_fence(__ATOMIC_ACQUIRE, "agent");
            xb_add(&bar[XB_XGEN(b.x)], 1u);
            asm volatile("s_waitcnt vmcnt(0)" ::: "memory");
        } else {
            XB_SPIN(xb_ld(&bar[XB_XGEN(b.x)]) == gen, bar);
            __builtin_amdgcn_fence(__ATOMIC_ACQUIRE, "agent");
            asm volatile("s_waitcnt vmcnt(0)" ::: "memory");
        }
    }
    __syncthreads();
}


__device__ __forceinline__ int otid() { int t = threadIdx.x; asm volatile("" : "+v"(t)); return t; }
__device__ __forceinline__ float wave_sum(float v) {
#pragma unroll
    for (int o = 1; o < 64; o <<= 1) v += __shfl_xor(v, o);
    return v;
}
__device__ __forceinline__ void transpose_item(const float* W, int N, const float* gain, bf16_t* WT, int ldk, int koff, int drow0, int k0, int n0, LAS float* scr, int lane) {
    const f32x4* src = (const f32x4*)(W + (size_t)(k0 + lane) * N + n0);
    f32x4 v[8];
#pragma unroll
    for (int j = 0; j < 8; ++j) v[j] = src[j];
    const float gsc = gain ? gain[k0 + lane] : 1.0f;
#pragma unroll
    for (int j = 0; j < 8; ++j) { scr[lane * 33 + 4 * j + 0] = v[j].x * gsc; scr[lane * 33 + 4 * j + 1] = v[j].y * gsc; scr[lane * 33 + 4 * j + 2] = v[j].z * gsc; scr[lane * 33 + 4 * j + 3] = v[j].w * gsc; }
    asm volatile("s_waitcnt lgkmcnt(0)" ::: "memory");
    const int c = lane & 7;
#pragma unroll
    for (int j = 0; j < 4; ++j) { const int n = (lane >> 3) + 8 * j; const LAS float* sp = scr + (8 * c) * 33 + n;
        u32x4 o; o.x = pk2(sp[0 * 33], sp[1 * 33]); o.y = pk2(sp[2 * 33], sp[3 * 33]); o.z = pk2(sp[4 * 33], sp[5 * 33]); o.w = pk2(sp[6 * 33], sp[7 * 33]);
        *(u32x4*)(WT + tiled_off(wslot(drow0 + n), koff + k0 + 8 * c, ldk >> 6)) = o; }
    asm volatile("s_waitcnt lgkmcnt(0)" ::: "memory");
}

struct Params {
    const float* in[18];
    float* out;
    unsigned char* ws;
};

__device__ __forceinline__ void norm_rows_bf16(const float* src, bf16_t* dst, int gw, int ngw, int lane) {
    for (int m = 2 * gw; m < MTOK; m += 2 * ngw) {
        const f32x4* xr = (const f32x4*)(src + (size_t)m * DM) + lane;
        f32x4 v[2][4]; float s0 = 0.f, s1 = 0.f;
#pragma unroll
        for (int j = 0; j < 4; ++j) { v[0][j] = xr[64 * j]; v[1][j] = xr[256 + 64 * j]; }
#pragma unroll
        for (int j = 0; j < 4; ++j) { s0 += (v[0][j].x * v[0][j].x + v[0][j].y * v[0][j].y) + (v[0][j].z * v[0][j].z + v[0][j].w * v[0][j].w);
                                      s1 += (v[1][j].x * v[1][j].x + v[1][j].y * v[1][j].y) + (v[1][j].z * v[1][j].z + v[1][j].w * v[1][j].w); }
        const float r0 = 1.0f / sqrtf(wave_sum(s0) * (1.0f / DM) + EPS), r1 = 1.0f / sqrtf(wave_sum(s1) * (1.0f / DM) + EPS);
#pragma unroll
        for (int j = 0; j < 4; ++j) { u32x2 w; w.x = pk2(v[0][j].x * r0, v[0][j].y * r0); w.y = pk2(v[0][j].z * r0, v[0][j].w * r0); *(u32x2*)(dst + tiled_off(m, 4 * lane + 256 * j, DM / 64)) = w;
                                      u32x2 w1; w1.x = pk2(v[1][j].x * r1, v[1][j].y * r1); w1.y = pk2(v[1][j].z * r1, v[1][j].w * r1); *(u32x2*)(dst + tiled_off(m + 1, 4 * lane + 256 * j, DM / 64)) = w1; }
    }
}
__device__ __forceinline__ void rowscale_phase(const float* ssq, float* rs, int gtid, int nth) {
    for (int row = gtid; row < MTOK; row += nth) {
        const f32x4* pp = (const f32x4*)(ssq + (size_t)row * 16);
        const f32x4 a = pp[0], b = pp[1], c = pp[2], d = pp[3];
        const float sum = ((a.x + a.y) + (a.z + a.w)) + ((b.x + b.y) + (b.z + b.w)) + ((c.x + c.y) + (c.z + c.w)) + ((d.x + d.y) + (d.z + d.w));
        rs[row] = 1.0f / sqrtf(sum * (1.0f / DM) + EPS);
    }
}

__device__ __forceinline__ void attn_load_block(LAS unsigned char* lds, const bf16_t* kp0, const bf16_t* vp0, int kvld, int tokbase, int d, int blk, int tid) {
    const int ch = tid & 7, rw = tid >> 3;
    u32x4 tmp[8];
#pragma unroll
    for (int i = 0; i < 8; ++i) { const int mat = i >> 1, row = rw + 64 * (i & 1); const int tok = tokbase + d * (blk * 128 + row);
        tmp[i] = *(const u32x4*)(((mat < 2) ? kp0 : vp0) + (size_t)tok * kvld + (mat & 1) * 64 + ch * 8); }
#pragma unroll
    for (int i = 0; i < 8; ++i) { const int mat = i >> 1, row = (blk & 1) * 128 + rw + 64 * (i & 1); *(LAS u32x4*)(lds + mat * 36864 + row * 144 + ch * 16) = tmp[i]; }
}
#define ATT_BAR() do { asm volatile("s_waitcnt lgkmcnt(0)" ::: "memory"); __builtin_amdgcn_s_barrier(); asm volatile("" ::: "memory"); } while (0)
__device__ __forceinline__ void attn_phase(LAS unsigned char* lds, bf16_t* Z, bf16_t* YAB, float* LSE, const float* lutg, const float* sinks, int G, int wg) {
    int tid_o = threadIdx.x; asm volatile("" : "+v"(tid_o));
    const int tid = tid_o, wv = __builtin_amdgcn_readfirstlane(tid >> 6), lane = tid & 63, r = lane & 31, h = lane >> 5;
    LAS float* lutl = (LAS float*)(lds + 147456);
    for (int sid = wg; sid < 1792; sid += G) {
        int isB, gi, d, hp, bt, rs, b0, len;
        if (sid < 256) { isB = 0; gi = 0; d = 1; const int chain = sid >> 2; hp = chain & 1; bt = chain >> 1; rs = 0; b0 = (sid & 3) * 4; len = 4; }
        else if (sid < 512) { const int c = sid - 256; isB = 0; gi = 1; d = 4; hp = c & 1; const int seq = c >> 1; bt = seq >> 2; rs = seq & 3; b0 = 0; len = 4; }
        else if (sid < 1536) { const int c = sid - 512; isB = 0; gi = 2; d = 16; hp = c & 1; const int seq = c >> 1; bt = seq >> 4; rs = seq & 15; b0 = 0; len = 1; }
        else { const int c = sid - 1536; isB = 1; gi = 0; d = 1; hp = 0; bt = c >> 3; rs = 0; b0 = (c & 7) * 2; len = 2; }
        const int tokbase = bt * SEQ + rs;
        const bf16_t* kp0 = isB ? (Z + ZO_KVB) : (Z + ZO_KA + (4 * gi + 2 * hp) * 64); const bf16_t* vp0 = isB ? (Z + ZO_KVB + 128) : (Z + ZO_VA + (4 * gi + 2 * hp) * 64);
        const int kvld = isB ? 256 : 768, qld = isB ? 512 : 768;
        for (int b = b0; b < b0 + len; ++b) {
        ATT_BAR();
        if (b == b0) {
            if (b0 > 0) attn_load_block(lds, kp0, vp0, kvld, tokbase, d, b0 - 1, tid);
            const int nh = isB ? 8 : 2, headbase = isB ? 12 : 4 * gi + 2 * hp;
            for (int idx = tid; idx < nh * LUTP; idx += 512) lutl[idx] = lutg[headbase * LUTP + idx];
        }
        attn_load_block(lds, kp0, vp0, kvld, tokbase, d, b, tid);
        ATT_BAR();
        const int nrounds = isB ? 4 : 1;
        for (int rd = 0; rd < nrounds; ++rd) {
            int slot, rt, qcol, lh, qh = 0; float sink = NEGBIG;
            if (!isB) { slot = wv >> 2; rt = wv & 3; qcol = (4 * gi + 2 * hp + slot) * 64; lh = slot; }
            else { const int tk = rd * 8 + wv; qh = tk >> 2; rt = tk & 3; slot = qh >> 2; qcol = qh * 64; lh = qh; sink = sinks[qh] * LOG2E; }
            bf16_t* qbase = Z + (isB ? ZO_QB : ZO_QA) + qcol;
            const int qi = 32 * rt + r;
            const size_t qtok = (size_t)(tokbase + d * (b * 128 + qi));
            const bf16_t* qp = qbase + qtok * qld + 8 * h;
            bf16x8 qf[4];
#pragma unroll
            for (int s = 0; s < 4; ++s) qf[s] = *(const bf16x8*)(qp + 16 * s);
            const LAS unsigned char* Ks = lds + slot * 36864;
            const LAS unsigned char* Vs = lds + 73728 + slot * 36864;
            const int dk_start = (b == 0) ? ((4 - rt) > 0 ? (4 - rt) : 0) : 0;
            f32x16 X[5];
            if (dk_start == 0) {
#pragma unroll
                for (int dk = 0; dk < 5; ++dk) {
                    const LAS float* lp = lutl + lh * LUTP + 32 + 128 - 32 * dk + r - 4 * h;
#pragma unroll
                    for (int i = 0; i < 16; ++i) X[dk][i] = lp[-((i & 3) + 8 * (i >> 2))];
                }
#pragma unroll
                for (int s = 0; s < 4; ++s) {
                    bf16x8 kf[5];
#pragma unroll
                    for (int dk = 0; dk < 5; ++dk) { const int kt = rt + dk; const int lrow = (((b - 1 + (kt >> 2)) & 1) << 7) + ((kt & 3) << 5);
                        kf[dk] = *(const LAS bf16x8*)(Ks + (lrow + r) * 144 + 16 * h + 32 * s); }
#pragma unroll
                    for (int dk = 0; dk < 5; ++dk) X[dk] = __builtin_amdgcn_mfma_f32_32x32x16_bf16(kf[dk], qf[s], X[dk], 0, 0, 0);
                }
            } else {
#pragma unroll
            for (int dk = 0; dk < 5; ++dk) {
                if (dk >= dk_start) {
                    const int kt = rt + dk;
                    const int lrow = (((b - 1 + (kt >> 2)) & 1) << 7) + ((kt & 3) << 5);
                    const LAS unsigned char* kp = Ks + (lrow + r) * 144 + 16 * h;
                    const LAS float* lp = lutl + lh * LUTP + 32 + 128 - 32 * dk + r - 4 * h;
                    f32x16 x;
#pragma unroll
                    for (int i = 0; i < 16; ++i) x[i] = lp[-((i & 3) + 8 * (i >> 2))];
                    bf16x8 kf[4];
#pragma unroll
                    for (int s = 0; s < 4; ++s) kf[s] = *(const LAS bf16x8*)(kp + 32 * s);
#pragma unroll
                    for (int s = 0; s < 4; ++s) x = __builtin_amdgcn_mfma_f32_32x32x16_bf16(kf[s], qf[s], x, 0, 0, 0);
                    X[dk] = x;
                } else {
#pragma unroll
                    for (int i = 0; i < 16; ++i) X[dk][i] = NEGBIG;
                }
            }
            }
            float mxp[4] = {NEGBIG, NEGBIG, NEGBIG, NEGBIG};
#pragma unroll
            for (int dk = 0; dk < 5; ++dk)
#pragma unroll
                for (int i = 0; i < 16; ++i) mxp[i & 3] = fmaxf(mxp[i & 3], X[dk][i]);
            float mx = fmaxf(fmaxf(mxp[0], mxp[1]), fmaxf(mxp[2], mxp[3]));
            mx = fmaxf(mx, __shfl_xor(mx, 32));
            mx = fmaxf(mx, sink);
            float lp4[4] = {0.f, 0.f, 0.f, 0.f};
#pragma unroll
            for (int dk = 0; dk < 5; ++dk)
#pragma unroll
                for (int i = 0; i < 16; ++i) { const float p = __builtin_amdgcn_exp2f(X[dk][i] - mx); X[dk][i] = p; lp4[i & 3] += p; }
            float l = (lp4[0] + lp4[1]) + (lp4[2] + lp4[3]);
            l += __shfl_xor(l, 32);
            if (isB) l += __builtin_amdgcn_exp2f(sink - mx);
            f32x16 O[2];
#pragma unroll
            for (int i = 0; i < 16; ++i) { O[0][i] = 0.f; O[1][i] = 0.f; }
            const int i16 = lane & 15, tq = i16 >> 2, tp = i16 & 3;
            const LAS unsigned char* vbase = Vs + (4 * h + tq) * 144 + 32 * ((lane >> 4) & 1) + 8 * tp;
#pragma unroll
            for (int dk = 0; dk < 5; ++dk) {
                if (dk >= dk_start) {
                    const int kt = rt + dk;
                    const int lrow = (((b - 1 + (kt >> 2)) & 1) << 7) + ((kt & 3) << 5);
#pragma unroll
                    for (int s = 0; s < 2; ++s) {
                        u32x4 pw; pw.x = pk2(X[dk][8 * s + 0], X[dk][8 * s + 1]); pw.y = pk2(X[dk][8 * s + 2], X[dk][8 * s + 3]); pw.z = pk2(X[dk][8 * s + 4], X[dk][8 * s + 5]); pw.w = pk2(X[dk][8 * s + 6], X[dk][8 * s + 7]);
                        const bf16x8 pf = __builtin_bit_cast(bf16x8, pw);
#pragma unroll
                        for (int dt = 0; dt < 2; ++dt) {
                            const LAS unsigned char* va = vbase + (lrow + 16 * s) * 144 + 64 * dt;
                            const s16x4 lo = __builtin_amdgcn_ds_read_tr16_b64_v4i16((LAS s16x4*)(va));
                            const s16x4 hi = __builtin_amdgcn_ds_read_tr16_b64_v4i16((LAS s16x4*)(va + 8 * 144));
                            const bf16x8 vf = __builtin_shufflevector(lo, hi, 0, 1, 2, 3, 4, 5, 6, 7);
                            O[dt] = __builtin_amdgcn_mfma_f32_32x32x16_bf16(vf, pf, O[dt], 0, 0, 0);
                        }
                    }
                }
            }
            const float inv = 1.0f / l;
            bf16_t* op = qbase + qtok * qld;
#pragma unroll
            for (int dt = 0; dt < 2; ++dt)
#pragma unroll
                for (int pr = 0; pr < 2; ++pr) {
                    const int ga = 2 * pr, gb = 2 * pr + 1;
                    const unsigned x0 = pk2(O[dt][4 * ga] * inv, O[dt][4 * ga + 1] * inv), x1 = pk2(O[dt][4 * ga + 2] * inv, O[dt][4 * ga + 3] * inv);
                    const unsigned y0 = pk2(O[dt][4 * gb] * inv, O[dt][4 * gb + 1] * inv), y1 = pk2(O[dt][4 * gb + 2] * inv, O[dt][4 * gb + 3] * inv);
                    const u32x2 s0 = __builtin_amdgcn_permlane32_swap(x0, y0, false, false), s1 = __builtin_amdgcn_permlane32_swap(x1, y1, false, false);
                    u32x4 w; w.x = s0.x; w.y = s1.x; w.z = s0.y; w.w = s1.y;
                    if (isB) *(u32x4*)(YAB + tiled_off((int)qtok, 256 + qcol + 32 * dt + 8 * (2 * pr + h), 12)) = w;
                    else *(u32x4*)(op + 32 * dt + 8 * (2 * pr + h)) = w;
                }
            if (!isB && h == 0) LSE[((size_t)gi * MTOK + qtok) * 4 + 2 * hp + slot] = mx + __builtin_amdgcn_logf(l);
        }
        }
    }
}

__device__ __forceinline__ void combine_phase(const bf16_t* Z, const float* LSE, bf16_t* YAB, int gtid, int nth) {
    for (int idx = gtid; idx < MTOK * 32; idx += nth) {
        const int tok = idx >> 5; const int c = (int)(idx & 31), s = c >> 3, e0 = (c & 7) * 8;
        const float l0 = LSE[((size_t)0 * MTOK + tok) * 4 + s], l1 = LSE[((size_t)1 * MTOK + tok) * 4 + s], l2 = LSE[((size_t)2 * MTOK + tok) * 4 + s];
        const float mx = fmaxf(l0, fmaxf(l1, l2));
        const float w0 = __builtin_amdgcn_exp2f(l0 - mx), w1 = __builtin_amdgcn_exp2f(l1 - mx), w2 = __builtin_amdgcn_exp2f(l2 - mx);
        const float inv = 1.0f / (w0 + w1 + w2);
        const float a0 = w0 * inv, a1 = w1 * inv, a2 = w2 * inv;
        const bf16_t* zr = Z + ZO_QA + (size_t)tok * 768 + s * 64 + e0;
        const u32x4 o0 = *(const u32x4*)(zr), o1 = *(const u32x4*)(zr + 256), o2 = *(const u32x4*)(zr + 512);
        u32x4 w;
#pragma unroll
        for (int q = 0; q < 4; ++q) {
            const float lo = a0 * bf_lo(o0[q]) + a1 * bf_lo(o1[q]) + a2 * bf_lo(o2[q]);
            const float hi = a0 * bf_hi(o0[q]) + a1 * bf_hi(o1[q]) + a2 * bf_hi(o2[q]);
            w[q] = pk2(lo, hi);
        }
        *(u32x4*)(YAB + tiled_off(tok, s * 64 + e0, 12)) = w;
    }
}

#ifndef DBG_A
#define DBG_A -1
#endif
#ifndef DBG_B
#define DBG_B -1
#endif
#ifndef DBG_DOUBLE
#define DBG_DOUBLE -1
#endif
#ifndef DBG_GEMM_PHASE
#define DBG_GEMM_PHASE -1
#endif
#define GDBG(k) ((DBG_GEMM_PHASE == (k)) ? (unsigned long long*)(p.ws + MiB) + 20 : (unsigned long long*)nullptr)
#define REP(k) for (int rep_ = 0; rep_ < ((DBG_DOUBLE == (k)) ? 2 : 1); ++rep_)
#define TSTAMP(k) do { if (DBG_A >= 0 && wg == 0 && threadIdx.x == 0) { ((unsigned long long*)(p.ws + MiB))[k] = __builtin_amdgcn_s_memrealtime(); ((unsigned long long*)(p.ws + MiB))[32 + k] = __builtin_amdgcn_s_memtime(); } } while (0)
#ifndef PHASE_MASK
#define PHASE_MASK 0xFFFFu
#endif
#define PH(k) ((PHASE_MASK >> (k)) & 1u)

__global__ void __launch_bounds__(512, 2) fwd_kernel(Params p) {
    extern __shared__ __attribute__((aligned(16))) unsigned char lds_raw[];
    LAS unsigned char* lds = (LAS unsigned char*)lds_raw;
    cg::grid_group grid = cg::this_grid();
    const int G = gridDim.x, wg = blockIdx.x, ngw = G * 8;
    if (threadIdx.x < 16) ((LAS unsigned*)(lds + LDS_CTL_OFF))[threadIdx.x] = 0u;
    __syncthreads();
    const XcdBarrier xbar = xcd_barrier_post((unsigned*)p.ws, (volatile LAS unsigned*)(lds + LDS_CTL_OFF));
#define PHASE_IDS const int tid = otid(), lane = tid & 63, wave = __builtin_amdgcn_readfirstlane(tid >> 6), gw = wg * 8 + wave; (void)lane; (void)gw;
#define Wgu1 ((bf16_t*)(p.ws + WS_WGU1))
#define Wd1 ((bf16_t*)(p.ws + WS_WD1))
#define Win ((bf16_t*)(p.ws + WS_WIN))
#define Wbr ((bf16_t*)(p.ws + WS_WBR))
#define Wout ((bf16_t*)(p.ws + WS_WOUT))
#define Wgu2 ((bf16_t*)(p.ws + WS_WGU2))
#define Wd2 ((bf16_t*)(p.ws + WS_WD2))
#define lutg ((float*)(p.ws + WS_LUT))
#define LSE ((float*)(p.ws + WS_LSE))
#define XN ((bf16_t*)(p.ws + WS_XN))
#define HB ((bf16_t*)(p.ws + WS_HB))
#define RS ((float*)(p.ws + WS_RS))
#define SSQ ((float*)(p.ws + WS_SSQ))
#define YAB ((bf16_t*)(p.ws + WS_XN))
#define Z ((bf16_t*)(p.ws + WS_Z))
#define HID ((bf16_t*)(p.ws + WS_Z))

    TSTAMP(0);
#ifdef DBG_XCC
    if (wg == 0 && threadIdx.x == 0) *((unsigned*)(p.ws + MiB + 4096)) = 0u;
#endif
    REP(0) if (PH(0)) {
        PHASE_IDS
        LAS float* scr = (LAS float*)(lds + wave * 16384);
        constexpr int I_GU = 16 * 88, I_DN = 44 * 32, I_IN = 16 * 160, I_BA = 4 * 32, I_BB = 8 * 32, I_OUT = 16 * 32;
        constexpr int NITEMS = 6 * I_GU + I_IN + I_BA + I_BB + I_OUT;
        for (int it = gw; it < NITEMS; it += ngw) {
            int rr = it;
            bool done = false;
#pragma unroll
            for (int f = 0; f < 4; ++f) {
                if (!done && rr < I_GU) { const int kb = rr / 88, nb = rr % 88, n0 = nb * 32; const int which = f & 1, layer = f >> 1;
                    const float* W = p.in[layer ? (which ? 15 : 14) : (which ? 3 : 2)]; const float* gain = p.in[layer ? 13 : 1];
                    transpose_item(W, DFF, gain, layer ? Wgu2 : Wgu1, DM, 0, (n0 / 128) * 256 + which * 128 + (n0 % 128), kb * 64, n0, scr, lane); done = true; }
                if (!done) rr -= I_GU;
            }
            if (done) continue;
            if (rr < I_DN) { transpose_item(p.in[4], DM, nullptr, Wd1, DFF, 0, (rr % 32) * 32, (rr / 32) * 64, (rr % 32) * 32, scr, lane); continue; } rr -= I_DN;
            if (rr < I_DN) { transpose_item(p.in[16], DM, nullptr, Wd2, DFF, 0, (rr % 32) * 32, (rr / 32) * 64, (rr % 32) * 32, scr, lane); continue; } rr -= I_DN;
            if (rr < I_IN) { transpose_item(p.in[6], DIN, p.in[5], Win, DM, 0, (rr % 160) * 32, (rr / 160) * 64, (rr % 160) * 32, scr, lane); continue; } rr -= I_IN;
            if (rr < I_BA) { transpose_item(p.in[8], DM, nullptr, Wbr, 768, 0, (rr % 32) * 32, (rr / 32) * 64, (rr % 32) * 32, scr, lane); continue; } rr -= I_BA;
            if (rr < I_BB) { transpose_item(p.in[9], DM, nullptr, Wbr, 768, 256, (rr % 32) * 32, (rr / 32) * 64, (rr % 32) * 32, scr, lane); continue; } rr -= I_BB;
            transpose_item(p.in[10], DM, nullptr, Wout, DM, 0, (rr % 32) * 32, (rr / 32) * 64, (rr % 32) * 32, scr, lane);
        }
        if (wg == 0) {
            const float* rel = p.in[12];
            for (int idx = tid; idx < 20 * LUTP; idx += 512) {
                const int hd = idx / LUTP, dist = idx % LUTP - 32;
                const int dil = (hd < 4) ? 1 : ((hd < 8) ? 4 : ((hd < 12) ? 16 : 1));
                const int maxs = (hd < 12) ? 128 : 127;
                float v = NEGBIG;
                if (dist >= 0 && dist <= maxs) {
                    const int n = dist * dil; int bucket;
                    if (n < 16) bucket = n;
                    else { const float nf = (float)n; int lg = 16 + (int)(logf(nf / 16.0f) / 4.852030263919617f * 16.0f); bucket = lg < 31 ? lg : 31; }
                    v = rel[bucket * 20 + hd] * LOG2E;
                }
                lutg[idx] = v;
            }
        }
        norm_rows_bf16(p.in[0], XN, gw, ngw, lane);
    }
    if (G > (1 << 24)) grid.sync();
    xcd_barrier(xbar); TSTAMP(1);
#ifdef DBG_XCC
    if (threadIdx.x == 0) { const unsigned xcc = (unsigned)__builtin_amdgcn_s_getreg((3 << 11) | 20) & 0xFu; if (xcc != (unsigned)(wg & 7)) atomicAdd((unsigned*)(p.ws + MiB + 4096), 1u); }
#endif
    REP(1) if (PH(1)) { pg8::Gemm g{XN, Wgu1, MTOK, 2 * DFF, DM, DM, 1, GDBG(1)}; pg8::StaticOrder S; S.init(MTOK, 2 * DFF, G, wg); pg8::EpiSwiGLU E{HID, nullptr}; pg8::gemm_phase<pg8::EpiSwiGLU, (DBG_GEMM_PHASE == 1)>(lds, g, S, E); }
    xcd_barrier(xbar); TSTAMP(2);
    REP(2) if (PH(2)) { pg8::Gemm g{HID, Wd1, MTOK, DM, DFF, DFF, 1, GDBG(2)}; pg8::StaticOrder S; S.init(MTOK, DM, G, wg); pg8::EpiHB<true> E{p.in[0], HB, SSQ, 0.5f}; pg8::gemm_phase<pg8::EpiHB<true>, (DBG_GEMM_PHASE == 2)>(lds, g, S, E); }
    xcd_barrier(xbar); TSTAMP(3);
    REP(3) if (PH(3)) rowscale_phase(SSQ, RS, wg * 512 + otid(), G * 512);
    xcd_barrier(xbar); TSTAMP(4);
    REP(4) if (PH(4)) { pg8::Gemm g{HB, Win, MTOK, DIN, DM, DM, 1, GDBG(4)}; pg8::StaticOrder S; S.init(MTOK, DIN, G, wg); pg8::EpiZ E{Z, p.in[7], RS}; pg8::gemm_phase<pg8::EpiZ, (DBG_GEMM_PHASE == 4)>(lds, g, S, E); }
    xcd_barrier(xbar); TSTAMP(5);
    REP(5) if (PH(5)) attn_phase(lds, Z, YAB, LSE, lutg, p.in[11], G, wg);
    xcd_barrier(xbar); TSTAMP(6);
    REP(6) if (PH(6)) combine_phase(Z, LSE, YAB, wg * 512 + otid(), G * 512);
    xcd_barrier(xbar); TSTAMP(7);
    REP(7) if (PH(7)) { pg8::Gemm g{YAB, Wbr, MTOK, DM, 768, 768, 1, GDBG(7)}; pg8::StaticOrder S; S.init(MTOK, DM, G, wg); pg8::EpiMerge E{Z + ZO_KA, Z}; pg8::gemm_phase<pg8::EpiMerge, (DBG_GEMM_PHASE == 7)>(lds, g, S, E); }
    xcd_barrier(xbar); TSTAMP(8);
    REP(8) if (PH(8)) { pg8::Gemm g{Z + ZO_KA, Wout, MTOK, DM, DM, DM, 1, GDBG(8)}; pg8::StaticOrder S; S.init(MTOK, DM, G, wg); pg8::EpiHB<false> E{nullptr, HB, SSQ, 1.0f}; pg8::gemm_phase<pg8::EpiHB<false>, (DBG_GEMM_PHASE == 8)>(lds, g, S, E); }
    xcd_barrier(xbar); TSTAMP(9);
    REP(9) if (PH(9)) rowscale_phase(SSQ, RS, wg * 512 + otid(), G * 512);
    xcd_barrier(xbar); TSTAMP(10);
    REP(10) if (PH(10)) { pg8::Gemm g{HB, Wgu2, MTOK, 2 * DFF, DM, DM, 1, GDBG(10)}; pg8::StaticOrder S; S.init(MTOK, 2 * DFF, G, wg); pg8::EpiSwiGLU E{HID, RS}; pg8::gemm_phase<pg8::EpiSwiGLU, (DBG_GEMM_PHASE == 10)>(lds, g, S, E); }
    xcd_barrier(xbar); TSTAMP(11);
    REP(11) if (PH(11)) { pg8::Gemm g{HID, Wd2, MTOK, DM, DFF, DFF, 1, GDBG(11)}; pg8::StaticOrder S; S.init(MTOK, DM, G, wg); pg8::EpiHB<false> E{nullptr, HB, SSQ, 0.5f}; pg8::gemm_phase<pg8::EpiHB<false>, (DBG_GEMM_PHASE == 11)>(lds, g, S, E); }
    xcd_barrier(xbar); TSTAMP(12);
    REP(12) if (PH(12)) {
        PHASE_IDS
        const float* gf = p.in[17];
        f32x4 gv[4];
#pragma unroll
        for (int j = 0; j < 4; ++j) gv[j] = *((const f32x4*)gf + lane + 64 * j);
        for (int m = 2 * gw; m < MTOK; m += 2 * ngw) {
            u32x2 hv[2][4]; float ps[2];
#pragma unroll
            for (int q = 0; q < 2; ++q) {
#pragma unroll
                for (int j = 0; j < 4; ++j) hv[q][j] = *(const u32x2*)(HB + tiled_off(m + q, 4 * lane + 256 * j, DM / 64));
                ps[q] = SSQ[(size_t)(m + q) * 16 + (lane & 15)];
            }
#pragma unroll
            for (int q = 0; q < 2; ++q) {
                float sum = ps[q];
#pragma unroll
                for (int o = 1; o < 16; o <<= 1) sum += __shfl_xor(sum, o);
                const float r = 1.0f / sqrtf(sum * (1.0f / DM) + EPS);
                f32x4* orow = (f32x4*)(p.out + (size_t)(m + q) * DM) + lane;
#pragma unroll
                for (int j = 0; j < 4; ++j) { const u32x2 a = hv[q][j]; orow[64 * j] = (f32x4){bf_lo(a.x), bf_hi(a.x), bf_lo(a.y), bf_hi(a.y)} * r * gv[j]; }
            }
        }
    }
    if (DBG_A >= 0) {
        grid.sync();
        if (wg == 0) { const unsigned long long* tsp = (const unsigned long long*)(p.ws + MiB);
#ifdef DBG_XCC
            const long n = 100 + 10 * (long)(*((const unsigned*)(p.ws + MiB + 4096)));
#else
#ifdef DBG_CLOCK
            const long n = (long)((tsp[32 + DBG_B] - tsp[32 + DBG_A]) * 100 / (tsp[DBG_B] - tsp[DBG_A]));
#else
            const long n = DBG_GEMM_MODE ? (long)(tsp[20] / 10) : (long)(tsp[DBG_B >= 0 ? DBG_B : 0] - tsp[DBG_A >= 0 ? DBG_A : 0]) / 10;
#endif
#endif

            for (long i = threadIdx.x; i < n; i += 512) p.out[(size_t)i * 997 + 3] += 0.1f; }
    }
}

#undef Z
#undef XN
#undef HB
#undef RS
#undef SSQ
#undef YAB
#undef HID
#undef LSE
#undef lutg
extern "C" void kernel_launch(void* const* d_in, const int* in_sizes, int n_in, void* d_out, int out_size, void* d_ws, size_t ws_size, hipStream_t stream) {
    static int grid = 0;
    if (grid == 0) {
        if (n_in != 18 || out_size != MTOK * DM || ws_size < WS_END) { fprintf(stderr, "kernel_launch: unexpected shapes (n_in %d out %d ws %zu)\n", n_in, out_size, ws_size); grid = -1; return; }
        int dev = 0, cus = 0, per_cu = 0;
        if (hipGetDevice(&dev) != hipSuccess || hipDeviceGetAttribute(&cus, hipDeviceAttributeMultiprocessorCount, dev) != hipSuccess) { grid = -1; return; }
        if (hipFuncSetAttribute((const void*)fwd_kernel, hipFuncAttributeMaxDynamicSharedMemorySize, LDS_BYTES) != hipSuccess) { fprintf(stderr, "hipFuncSetAttribute failed\n"); grid = -1; return; }
        if (hipOccupancyMaxActiveBlocksPerMultiprocessor(&per_cu, (const void*)fwd_kernel, 512, LDS_BYTES) != hipSuccess || per_cu < 1) per_cu = 1;
        (void)hipGetLastError();
        grid = cus * per_cu;
    }
    if (grid < 0) return;
    if (hipMemsetAsync(d_ws, 0, XCD_BAR_WORDS * 4, stream) != hipSuccess) { fprintf(stderr, "memset failed\n"); return; }
    Params p{};
    for (int i = 0; i < 18; ++i) p.in[i] = (const float*)d_in[i];
    p.out = (float*)d_out; p.ws = (unsigned char*)d_ws;
    void* args[] = {&p};
    hipError_t e = hipLaunchCooperativeKernel((const void*)fwd_kernel, dim3(grid), dim3(512), args, LDS_BYTES, stream);
    if (e != hipSuccess) fprintf(stderr, "cooperative launch failed: %s (grid %d)\n", hipGetErrorString(e), grid);
}
```

```cpp
#include <hip/hip_runtime.h>
#include <hip/hip_cooperative_groups.h>
#include <cstdio>
namespace cg = cooperative_groups;

#define LAS __attribute__((address_space(3)))
typedef unsigned short bf16_t;
typedef short bf16x8 __attribute__((ext_vector_type(8)));
typedef short s16x4 __attribute__((ext_vector_type(4)));
typedef float f32x4 __attribute__((ext_vector_type(4)));
typedef float f32x2 __attribute__((ext_vector_type(2)));
typedef float f32x16 __attribute__((ext_vector_type(16)));
typedef unsigned u32x4 __attribute__((ext_vector_type(4)));
typedef unsigned u32x2 __attribute__((ext_vector_type(2)));
typedef __bf16 bf16x2v __attribute__((ext_vector_type(2)));

constexpr int MTOK = 65536, DM = 1024, DFF = 2816, DIN = 5120, SEQ = 2048;
constexpr float EPS = 1e-6f, LOG2E = 1.4426950408889634f, QSCALE = 0.125f * 1.4426950408889634f, NEGBIG = -1e30f;
constexpr int ZAQ = 0, ZAK = 768, ZAV = 1536, ZBQ = 2304, ZBK = 2816, ZBV = 2944, ZGA = 3072, ZGB = 4096;
constexpr size_t ZO_KA = 0, ZO_VA = (size_t)MTOK * 768, ZO_QA = (size_t)MTOK * 1536, ZO_QB = (size_t)MTOK * 2304, ZO_KVB = (size_t)MTOK * 2816, ZO_G = (size_t)MTOK * 3072;
constexpr int LUTP = 192;
constexpr int LDS_CTL_OFF = 147456 + 8 * LUTP * 4;
constexpr int LDS_BYTES = LDS_CTL_OFF + 64;

constexpr size_t MiB = 1u << 20;
constexpr size_t WS_WGU1 = 2 * MiB, WS_WD1 = 14 * MiB, WS_WIN = 20 * MiB, WS_WBR = 30 * MiB, WS_WOUT = 32 * MiB, WS_WGU2 = 34 * MiB, WS_WD2 = 46 * MiB;
constexpr size_t WS_LUT = 52 * MiB, WS_LSE = 53 * MiB, WS_RS = 56 * MiB, WS_SSQ = 57 * MiB, WS_XN = 64 * MiB, WS_HB = 192 * MiB, WS_Z = 320 * MiB, WS_END = 960 * MiB;

__device__ __forceinline__ unsigned pk2(float lo, float hi) { f32x2 f = {lo, hi}; return __builtin_bit_cast(unsigned, __builtin_convertvector(f, bf16x2v)); }
__device__ __forceinline__ float bf_lo(unsigned u) { return __uint_as_float(u << 16); }
__device__ __forceinline__ float bf_hi(unsigned u) { return __uint_as_float(u & 0xffff0000u); }
__device__ __forceinline__ float fast_sigmoid(float v) { return __builtin_amdgcn_rcpf(1.0f + __builtin_amdgcn_exp2f(-v * LOG2E)); }

__device__ __forceinline__ size_t tiled_off(int row, int col, int ktiles) {
    const int r = row & 127, c = col & 63;
    const int st = (r >> 4) * 2 + (c >> 5), ob = (r & 15) * 64 + (c & 31) * 2;
    const int byte = st * 1024 + (ob ^ (((ob >> 9) & 1) << 5));
    return ((size_t)(((row >> 8) * ktiles + (col >> 6)) * 2 + ((row >> 7) & 1))) * 8192 + (byte >> 1);
}
__device__ __forceinline__ int wslot(int x) { return (x & ~31) | ((((x >> 2) & 1) << 4) | (((x >> 3) & 3) << 2) | (x & 3)); }
__device__ __forceinline__ const char* uni_ptr(const char* p) { const unsigned long long v = (unsigned long long)p; const unsigned lo = __builtin_amdgcn_readfirstlane((unsigned)v), hi = __builtin_amdgcn_readfirstlane((unsigned)(v >> 32)); return (const char*)(((unsigned long long)hi << 32) | lo); }
namespace pg8 {
constexpr int BM = 256, BK = 64, HALF = 128, HTB = HALF * BK * 2, STAGE_BYTES = 8 * HTB, NXCD = 8, WGM = 8;
__host__ __device__ __forceinline__ int lds_byte(int r, int c) { const int st = (r >> 4) * 2 + (c >> 5), rr = r & 15, cc = c & 31, ob = rr * 64 + cc * 2; return st * 1024 + (ob ^ (((ob >> 9) & 1) << 5)); }
__host__ __device__ __forceinline__ void stage_rc(int b, int& R, int& C) { const int st = b / 1024, sb = b % 1024, swz = sb ^ (((sb >> 9) & 1) << 5); R = (st >> 1) * 16 + swz / 64; C = (st & 1) * 32 + (swz % 64) / 2; }
__host__ __device__ __forceinline__ int perm32(int rho) { const int n = rho >> 4, i = rho & 15; return 8 * (i >> 2) + 4 * n + (i & 3); }
struct Unit { int pm, pn; };
struct Gemm { const bf16_t* A; const bf16_t* Bt; int M, N, K; int lda; int a_tiled; unsigned long long* dbg; };
struct StaticOrder {
    int nM, nN, nwg, G, c;
    __device__ void init(int M, int N, int G_, int c_) { nM = M / BM; nN = N / BM; nwg = nM * nN; G = G_; c = c_; }
    __device__ bool next(int i, Unit& u) const {
        const long L = (long)i * G + c; if (L >= nwg) return false;
        int wgid = (int)L; { const int q = nwg / NXCD, r = nwg % NXCD, xcd = wgid % NXCD, off = wgid / NXCD; wgid = (xcd < r ? xcd * (q + 1) : r * (q + 1) + (xcd - r) * q) + off; }
        const int nig = WGM * nN, gid = wgid / nig, fm = gid * WGM, gsz = (nM - fm) < WGM ? (nM - fm) : WGM;
        u.pm = fm + ((wgid % nig) % gsz); u.pn = (wgid % nig) / gsz; return true;
    }
};

typedef f32x4 Acc[2][2][4][2];

struct EpiSwiGLU {
    static constexpr bool PERM = true; static constexpr int MID_T = -1;
    bf16_t* O; const float* rs;
    __device__ __forceinline__ void mid(Acc&, const Unit&, int, int, int, int) const {}
    __device__ __forceinline__ void operator()(const Acc& acc, const Unit& u, int wr, int wc, int fr, int fq) const {
        int opq; asm volatile("v_mov_b32 %0, 0" : "=v"(opq));
        const int row0 = u.pm * BM + wr * 64 + fr + opq;
        float rsv[2][4];
#pragma unroll
        for (int ai = 0; ai < 2; ++ai)
#pragma unroll
            for (int m = 0; m < 4; ++m) rsv[ai][m] = rs ? rs[row0 + ai * HALF + m * 16] : 1.0f;
#pragma unroll
        for (int ai = 0; ai < 2; ++ai)
#pragma unroll
            for (int m = 0; m < 4; ++m) {
                bf16_t* rowp = O + tiled_off(row0 + ai * HALF + m * 16, u.pn * 128 + wc * 32 + 8 * fq, DFF / 64);
                float hv[8];
#pragma unroll
                for (int n = 0; n < 2; ++n)
#pragma unroll
                    for (int j = 0; j < 4; ++j) { const float g = acc[ai][0][m][n][j] * rsv[ai][m], up = acc[ai][1][m][n][j] * rsv[ai][m]; hv[4 * n + j] = g * fast_sigmoid(g) * up; }
                u32x4 w; w.x = pk2(hv[0], hv[1]); w.y = pk2(hv[2], hv[3]); w.z = pk2(hv[4], hv[5]); w.w = pk2(hv[6], hv[7]);
                *(u32x4*)rowp = w;
            }
    }
};
template <bool BASE_F32> struct EpiHB {
    static constexpr bool PERM = true; static constexpr int MID_T = -1;
    const float* xbase; bf16_t* hb; float* ssq; float scale;
    __device__ __forceinline__ void mid(Acc&, const Unit&, int, int, int, int) const {}
    __device__ __forceinline__ void operator()(const Acc& acc, const Unit& u, int wr, int wc, int fr, int fq) const {
        int opq; asm volatile("v_mov_b32 %0, 0" : "=v"(opq));
        const int row0 = u.pm * BM + wr * 64 + fr + opq, col0 = u.pn * BM + wc * 32 + 8 * fq;
#pragma unroll
        for (int ai = 0; ai < 2; ++ai) {
            f32x4 bx[BASE_F32 ? 4 : 1][2][2]; u32x4 bh[BASE_F32 ? 1 : 4][2];
#pragma unroll
            for (int m = 0; m < 4; ++m) {
                const size_t off = (size_t)(row0 + ai * HALF + m * 16) * DM + col0;
#pragma unroll
                for (int bj = 0; bj < 2; ++bj) {
                    if constexpr (BASE_F32) { bx[m][bj][0] = *(const f32x4*)(xbase + off + bj * HALF); bx[m][bj][1] = *(const f32x4*)(xbase + off + bj * HALF + 4); }
                    else bh[m][bj] = *(const u32x4*)(hb + tiled_off(row0 + ai * HALF + m * 16, col0 + bj * HALF, DM / 64));
                }
            }
            asm volatile("" ::: "memory");
#pragma unroll
            for (int m = 0; m < 4; ++m) {
                const size_t off = (size_t)(row0 + ai * HALF + m * 16) * DM + col0;
                float sq = 0.f;
#pragma unroll
                for (int bj = 0; bj < 2; ++bj) {
                    f32x4 v0, v1;
                    if constexpr (BASE_F32) { v0 = bx[m][bj][0]; v1 = bx[m][bj][1]; }
                    else { const u32x4 b = bh[m][bj]; v0 = (f32x4){bf_lo(b.x), bf_hi(b.x), bf_lo(b.y), bf_hi(b.y)}; v1 = (f32x4){bf_lo(b.z), bf_hi(b.z), bf_lo(b.w), bf_hi(b.w)}; }
                    v0 += acc[ai][bj][m][0] * scale; v1 += acc[ai][bj][m][1] * scale;
                    sq += (v0[0] * v0[0] + v0[1] * v0[1]) + (v0[2] * v0[2] + v0[3] * v0[3]) + (v1[0] * v1[0] + v1[1] * v1[1]) + (v1[2] * v1[2] + v1[3] * v1[3]);
                    u32x4 w; w.x = pk2(v0[0], v0[1]); w.y = pk2(v0[2], v0[3]); w.z = pk2(v1[0], v1[1]); w.w = pk2(v1[2], v1[3]);
                    *(u32x4*)(hb + tiled_off(row0 + ai * HALF + m * 16, col0 + bj * HALF, DM / 64)) = w;
                }
                sq += __shfl_xor(sq, 16); sq += __shfl_xor(sq, 32);
                if (fq == 0) ssq[(size_t)(row0 + ai * HALF + m * 16) * 16 + u.pn * 4 + wc] = sq;
            }
            asm volatile("" ::: "memory");
        }
    }
};
struct EpiZ {
    static constexpr bool PERM = true; static constexpr int MID_T = -1;
    bf16_t* O; const float* bias; const float* rs;
    __device__ __forceinline__ void mid(Acc&, const Unit&, int, int, int, int) const {}
    __device__ __forceinline__ void operator()(const Acc& acc, const Unit& u, int wr, int wc, int fr, int fq) const {
        int opq; asm volatile("v_mov_b32 %0, 0" : "=v"(opq));
        const int row0 = u.pm * BM + wr * 64 + fr + opq, col0 = u.pn * BM + wc * 32 + 8 * fq;
        float rsv[2][4];
#pragma unroll
        for (int ai = 0; ai < 2; ++ai)
#pragma unroll
            for (int m = 0; m < 4; ++m) rsv[ai][m] = rs[row0 + ai * HALF + m * 16];
        const bool isq = (u.pn < 3) || (u.pn == 9) || (u.pn == 10), isg = (u.pn >= 12);
        const int pn = u.pn; size_t bo; int ld, c0;
        if (pn < 3) { bo = ZO_QA; ld = 768; c0 = pn * 256; } else if (pn < 6) { bo = ZO_KA; ld = 768; c0 = (pn - 3) * 256; } else if (pn < 9) { bo = ZO_VA; ld = 768; c0 = (pn - 6) * 256; }
        else if (pn < 11) { bo = ZO_QB; ld = 512; c0 = (pn - 9) * 256; } else if (pn == 11) { bo = ZO_KVB; ld = 256; c0 = 0; } else { bo = ZO_G; ld = 2048; c0 = (pn - 12) * 256; }
        bf16_t* blk = O + bo; const int cb = c0 + wc * 32 + 8 * fq;
        const float sc = isq ? QSCALE : 1.0f;
        f32x4 bv[2][2];
#pragma unroll
        for (int bj = 0; bj < 2; ++bj)
#pragma unroll
            for (int n = 0; n < 2; ++n) bv[bj][n] = *(const f32x4*)(bias + col0 + bj * HALF + 4 * n);
#pragma unroll
        for (int ai = 0; ai < 2; ++ai)
#pragma unroll
            for (int m = 0; m < 4; ++m) {
                bf16_t* rowp = blk + (size_t)(row0 + ai * HALF + m * 16) * ld + cb;
#pragma unroll
                for (int bj = 0; bj < 2; ++bj) {
                    f32x4 v0 = (acc[ai][bj][m][0] * rsv[ai][m] + bv[bj][0]) * sc, v1 = (acc[ai][bj][m][1] * rsv[ai][m] + bv[bj][1]) * sc;
                    if (isg) {
                        unsigned q0 = 0, q1 = 0;
#pragma unroll
                        for (int j = 0; j < 4; ++j) { q0 = __builtin_amdgcn_cvt_pk_u8_f32(fast_sigmoid(v0[j]) * 255.0f, j, q0); q1 = __builtin_amdgcn_cvt_pk_u8_f32(fast_sigmoid(v1[j]) * 255.0f, j, q1); }
                        u32x2 w8; w8.x = q0; w8.y = q1;
                        *(u32x2*)((unsigned char*)(O + ZO_G) + (size_t)(row0 + ai * HALF + m * 16) * 2048 + c0 + wc * 32 + 8 * fq + bj * HALF) = w8;
                        continue;
                    }
                    u32x4 w; w.x = pk2(v0[0], v0[1]); w.y = pk2(v0[2], v0[3]); w.z = pk2(v1[0], v1[1]); w.w = pk2(v1[2], v1[3]);
                    *(u32x4*)(rowp + bj * HALF) = w;
                }
            }
    }
};
struct EpiMerge {
    static constexpr bool PERM = true; static constexpr int MID_T = 2;
    bf16_t* O; const bf16_t* Z;
    __device__ __forceinline__ void mid(Acc& acc, const Unit& u, int wr, int wc, int fr, int fq) const {
        int opq; asm volatile("v_mov_b32 %0, 0" : "=v"(opq));
        const int row0 = u.pm * BM + wr * 64 + fr + opq, col0 = u.pn * BM + wc * 32 + 8 * fq;
        const unsigned char* G8 = (const unsigned char*)(Z + ZO_G);
        u32x2 sa[2][4][2], sb[2][4][2];
#pragma unroll
        for (int ai = 0; ai < 2; ++ai)
#pragma unroll
            for (int m = 0; m < 4; ++m) {
                const unsigned char* zr = G8 + (size_t)(row0 + ai * HALF + m * 16) * 2048 + col0;
#pragma unroll
                for (int bj = 0; bj < 2; ++bj) { sa[ai][m][bj] = *(const u32x2*)(zr + bj * HALF); sb[ai][m][bj] = *(const u32x2*)(zr + 1024 + bj * HALF); }
            }
        asm volatile("" ::: "memory");
#pragma unroll
        for (int ai = 0; ai < 2; ++ai)
#pragma unroll
            for (int m = 0; m < 4; ++m)
#pragma unroll
                for (int bj = 0; bj < 2; ++bj)
#pragma unroll
                    for (int n = 0; n < 2; ++n)
#pragma unroll
                        for (int j = 0; j < 4; ++j) {
                            const float qa = (float)((sa[ai][m][bj][n] >> (8 * j)) & 255u), qb = fmaxf((float)((sb[ai][m][bj][n] >> (8 * j)) & 255u), 0.5f);
                            acc[ai][bj][m][n][j] *= qa * __builtin_amdgcn_rcpf(qb);
                        }
        asm volatile("" : "+v"(acc[0][0][0][0]), "+v"(acc[1][1][3][1]) :: "memory");
    }
    __device__ __forceinline__ void operator()(const Acc& acc, const Unit& u, int wr, int wc, int fr, int fq) const {
        const int row0 = u.pm * BM + wr * 64 + fr, col0 = u.pn * BM + wc * 32 + 8 * fq;
        const unsigned char* G8 = (const unsigned char*)(Z + ZO_G);
        u32x2 sbv[2][4][2];
#pragma unroll
        for (int ai = 0; ai < 2; ++ai)
#pragma unroll
            for (int m = 0; m < 4; ++m) {
                const unsigned char* zr = G8 + (size_t)(row0 + ai * HALF + m * 16) * 2048 + col0;
#pragma unroll
                for (int bj = 0; bj < 2; ++bj) sbv[ai][m][bj] = *(const u32x2*)(zr + 1024 + bj * HALF);
            }
        asm volatile("" ::: "memory");
#pragma unroll
        for (int ai = 0; ai < 2; ++ai)
#pragma unroll
            for (int m = 0; m < 4; ++m) {
                const int orow = row0 + ai * HALF + m * 16;
#pragma unroll
                for (int bj = 0; bj < 2; ++bj) {
                    float o[8];
#pragma unroll
                    for (int n = 0; n < 2; ++n)
#pragma unroll
                        for (int j = 0; j < 4; ++j) o[4 * n + j] = acc[ai][bj][m][n][j] * (fmaxf((float)((sbv[ai][m][bj][n] >> (8 * j)) & 255u), 0.5f) * (1.0f / 255.0f));
                    u32x4 w; w.x = pk2(o[0], o[1]); w.y = pk2(o[2], o[3]); w.z = pk2(o[4], o[5]); w.w = pk2(o[6], o[7]);
                    *(u32x4*)(O + tiled_off(orow, col0 + bj * HALF, DM / 64)) = w;
                }
            }
    }
};

template <class Epi, bool DBGP = false>
__device__ __forceinline__ void gemm_phase(LAS unsigned char* lds, const Gemm g, const StaticOrder& S, const Epi& E) {
    int tid_o = threadIdx.x; asm volatile("" : "+v"(tid_o));
    const int tid = tid_o, wid = __builtin_amdgcn_readfirstlane(tid >> 6), lane = tid & 63, wr = wid >> 2, wc = wid & 3, fr = lane & 15, fq = lane >> 4;
    const int K = g.K, nt = K / BK;
    unsigned voffA[2], voffB[2];
#pragma unroll
    for (int i = 0; i < 2; ++i) { int R, C; stage_rc(tid * 16 + i * 8192, R, C); const int Rb = Epi::PERM ? ((R & ~31) + perm32(R & 31)) : R;
        (void)Rb; voffA[i] = g.a_tiled ? (unsigned)(tid * 16 + i * 8192) : (unsigned)(R * g.lda + C) * 2u; voffB[i] = (unsigned)(tid * 16 + i * 8192); }
    const size_t kstep = (size_t)(BM * BK * 2);
    const size_t hstep = (size_t)(HALF * BK * 2);
    const size_t tstep = (size_t)BM * K * 2;
    const size_t kstepA = g.a_tiled ? kstep : (size_t)(BK * 2), hstepA = g.a_tiled ? hstep : (size_t)HALF * g.lda * 2;
    const size_t tstepA = g.a_tiled ? tstep : 2 * hstepA;
    const unsigned ldsw = (unsigned)wid * 1024u;
    const int aoff = lds_byte(wr * 64 + fr, fq * 8), boff = lds_byte(wc * 32 + fr, fq * 8);
#define PG8_SA(b, h) (((b) * 2 + (h)) * HTB)
#define PG8_SB(b, h) ((4 + (b) * 2 + (h)) * HTB)
#define PG8_STAGE(bufoff, gbase, voff) do { _Pragma("unroll") for (int _i = 0; _i < 2; ++_i) \
        __builtin_amdgcn_global_load_lds((const unsigned*)((const char*)(gbase) + (voff)[_i]), (LAS unsigned*)(lds + (bufoff) + ldsw + _i * 8192), 16, 0, 0); } while (0)
#define PG8_LDA(dst, b, h) do { _Pragma("unroll") for (int m = 0; m < 4; ++m) _Pragma("unroll") for (int k = 0; k < 2; ++k) dst[m][k] = *(const LAS bf16x8*)(lds + PG8_SA(b, h) + aoff + m * 2048 + k * 1024); } while (0)
#define PG8_LDB(dst, b, h) do { _Pragma("unroll") for (int n = 0; n < 2; ++n) _Pragma("unroll") for (int k = 0; k < 2; ++k) dst[n][k] = *(const LAS bf16x8*)(lds + PG8_SB(b, h) + boff + n * 2048 + k * 1024); } while (0)
#define PG8_MMA(ai, bj, At, Bt) do { __builtin_amdgcn_s_setprio(1); _Pragma("unroll") for (int m = 0; m < 4; ++m) _Pragma("unroll") for (int n = 0; n < 2; ++n) _Pragma("unroll") for (int k = 0; k < 2; ++k) \
        acc[ai][bj][m][n] = __builtin_amdgcn_mfma_f32_16x16x32_bf16(Bt[n][k], At[m][k], acc[ai][bj][m][n], 0, 0, 0); __builtin_amdgcn_s_setprio(0); } while (0)
#define PG8_WAIT_V(n) asm volatile("s_waitcnt vmcnt(" #n ")" ::: "memory")
#define PG8_WAIT_L(n) asm volatile("s_waitcnt lgkmcnt(" #n ")" ::: "memory")
#define PG8_BAR __builtin_amdgcn_s_barrier()
#define PG8_SCHED __builtin_amdgcn_sched_barrier(0)
#ifndef DBG_GEMM_MODE
#define DBG_GEMM_MODE 0
#endif
    unsigned long long dbg_acc = 0, dbg_t0 = 0; (void)dbg_t0;
    Unit cur, nxt; int ui = 0;
    if (!S.next(0, cur)) return;
    Acc acc;
#pragma unroll
    for (int a = 0; a < 2; ++a)
#pragma unroll
        for (int b = 0; b < 2; ++b)
#pragma unroll
            for (int m = 0; m < 4; ++m)
#pragma unroll
                for (int n = 0; n < 2; ++n) acc[a][b][m][n] = (f32x4){0.f, 0.f, 0.f, 0.f};
    bf16x8 At[4][2], B0[2][2], B1[2][2];
    const char* cA = uni_ptr((const char*)g.A + (size_t)cur.pm * tstepA); const char* cB = uni_ptr((const char*)g.Bt + (size_t)cur.pn * tstep);
    PG8_STAGE(PG8_SB(0, 0), cB, voffB); PG8_STAGE(PG8_SB(0, 1), cB + hstep, voffB); PG8_STAGE(PG8_SA(0, 0), cA, voffA); PG8_STAGE(PG8_SA(0, 1), cA + hstepA, voffA);
    if (wr == 1) PG8_BAR;
    PG8_WAIT_V(2); PG8_BAR;
    PG8_STAGE(PG8_SB(1, 0), cB + kstep, voffB); PG8_STAGE(PG8_SA(1, 0), cA + kstepA, voffA); PG8_STAGE(PG8_SB(1, 1), cB + hstep + kstep, voffB);
    PG8_WAIT_V(6); PG8_BAR;
    for (;;) {
        const bool has_next = S.next(ui + 1, nxt);
        const char* nA = uni_ptr(has_next ? (const char*)g.A + (size_t)nxt.pm * tstepA : cA); const char* nB = uni_ptr(has_next ? (const char*)g.Bt + (size_t)nxt.pn * tstep : cB);
        if (DBG_GEMM_MODE == 3 && DBGP) dbg_t0 = __builtin_amdgcn_s_memrealtime();
        if (DBG_GEMM_MODE == 5 && DBGP && ui > 0) dbg_acc += __builtin_amdgcn_s_memrealtime() - dbg_t0;
        for (int t = 0; t < nt; t += 2) {
            if (DBG_GEMM_MODE == 2 && DBGP && t == 2) dbg_t0 = __builtin_amdgcn_s_memrealtime();
            if (DBG_GEMM_MODE == 3 && DBGP && t == 2) dbg_acc += __builtin_amdgcn_s_memrealtime() - dbg_t0;
            const bool last = (t == nt - 2);
            const char* a1 = cA + (size_t)(t + 1) * kstepA;
            const char* a2 = last ? nA : cA + (size_t)(t + 2) * kstepA; const char* b2 = last ? nB : cB + (size_t)(t + 2) * kstep;
            const char* a3 = a2 + kstepA; const char* b3 = b2 + kstep;
            PG8_LDB(B0, 0, 0); PG8_LDB(B1, 0, 1); PG8_SCHED; PG8_LDA(At, 0, 0); PG8_STAGE(PG8_SA(1, 1), a1 + hstepA, voffA);
            PG8_WAIT_V(8); PG8_WAIT_L(0); PG8_BAR; PG8_MMA(0, 0, At, B0); PG8_MMA(0, 1, At, B1); PG8_BAR; PG8_SCHED;
            PG8_LDA(At, 0, 1); PG8_STAGE(PG8_SB(0, 0), b2, voffB); PG8_STAGE(PG8_SB(0, 1), b2 + hstep, voffB); PG8_STAGE(PG8_SA(0, 0), a2, voffA);
            PG8_WAIT_V(8); PG8_WAIT_L(0); PG8_BAR; PG8_MMA(1, 0, At, B0); PG8_MMA(1, 1, At, B1); PG8_BAR; PG8_SCHED;
            PG8_LDB(B0, 1, 0); PG8_LDB(B1, 1, 1); PG8_SCHED; PG8_LDA(At, 1, 0); PG8_STAGE(PG8_SA(0, 1), a2 + hstepA, voffA);
            PG8_WAIT_V(8); PG8_WAIT_L(0); PG8_BAR; PG8_MMA(0, 0, At, B0); PG8_MMA(0, 1, At, B1); PG8_BAR; PG8_SCHED;
            PG8_LDA(At, 1, 1); PG8_STAGE(PG8_SB(1, 0), b3, voffB); PG8_STAGE(PG8_SB(1, 1), b3 + hstep, voffB); PG8_STAGE(PG8_SA(1, 0), a3, voffA);
            PG8_WAIT_V(8); PG8_WAIT_L(0); PG8_BAR; PG8_MMA(1, 0, At, B0); PG8_MMA(1, 1, At, B1); PG8_BAR; PG8_SCHED;
            if constexpr (Epi::MID_T >= 0) { if (t == Epi::MID_T) { E.mid(acc, cur, wr, wc, fr, fq); PG8_SCHED; } }
        }
        if (DBG_GEMM_MODE == 2 && DBGP) dbg_acc += __builtin_amdgcn_s_memrealtime() - dbg_t0;
        if (DBG_GEMM_MODE == 5 && DBGP) dbg_t0 = __builtin_amdgcn_s_memrealtime();
        if (wr == 0) PG8_BAR;
        if (DBG_GEMM_MODE == 1 && DBGP) dbg_t0 = __builtin_amdgcn_s_memrealtime();
        E(acc, cur, wr, wc, fr, fq);
#ifdef DBG_EPI2
        if (DBGP) { asm volatile("" ::: "memory"); E(acc, cur, wr, wc, fr, fq); }
#endif
        if (DBG_GEMM_MODE == 1 && DBGP) dbg_acc += __builtin_amdgcn_s_memrealtime() - dbg_t0;
        if (!has_next) break;
#pragma unroll
        for (int a = 0; a < 2; ++a)
#pragma unroll
            for (int b = 0; b < 2; ++b)
#pragma unroll
                for (int m = 0; m < 4; ++m)
#pragma unroll
                    for (int n = 0; n < 2; ++n) acc[a][b][m][n] = (f32x4){0.f, 0.f, 0.f, 0.f};
        cur = nxt; cA = nA; cB = nB; ++ui;
        if (wr == 1) PG8_BAR;
    }
    PG8_WAIT_V(0);
    PG8_BAR;
    if (DBG_GEMM_MODE && DBGP && blockIdx.x == 0 && tid == 0) *g.dbg = dbg_acc;
#undef PG8_SA
#undef PG8_SB
#undef PG8_STAGE
#undef PG8_LDA
#undef PG8_LDB
#undef PG8_MMA
#undef PG8_WAIT_V
#undef PG8_WAIT_L
#undef PG8_BAR
#undef PG8_SCHED
}
}

#define XB_TMO      128
#define XB_XCNT(j)  (256  + 64 * (j))
#define XB_XSUB(j)  (1280 + 64 * (j))
#define XB_XGEN(j)  (2304 + 64 * (j))
#define XB_TOP      3328
#define XB_TOPGEN   3392
#define XCD_BAR_WORDS 3456
#define XB_SPIN_CAP (1u << 18)

__device__ __forceinline__ unsigned xb_ld(unsigned* p)              { return __hip_atomic_load(p, __ATOMIC_RELAXED, __HIP_MEMORY_SCOPE_AGENT); }
__device__ __forceinline__ unsigned xb_add(unsigned* p, unsigned v) { return __hip_atomic_fetch_add(p, v, __ATOMIC_RELAXED, __HIP_MEMORY_SCOPE_AGENT); }
__device__ __forceinline__ unsigned xb_xcc_id() { return (unsigned)__builtin_amdgcn_s_getreg((3 << 11) | 20) & 0xFu; }
#define XB_SPIN(cond, bar) do { unsigned _sp = 0; while (cond) { __builtin_amdgcn_s_sleep(1); \
    if ((++_sp & 255u) == 0u) { if (xb_ld(&(bar)[XB_TMO])) break; if (_sp > XB_SPIN_CAP) { atomicAdd(&(bar)[XB_TMO], 1u); break; } } } } while (0)

struct XcdBarrier {
    unsigned* bar; unsigned x;
    volatile LAS unsigned* st;
};

__device__ __forceinline__ XcdBarrier xcd_barrier_post(unsigned* bar, volatile LAS unsigned* st) {
    XcdBarrier b; b.bar = bar; b.x = xb_xcc_id(); b.st = st;
    if (threadIdx.x == 0) (void)xb_add(&bar[XB_XCNT(b.x)], 1u);
    return b;
}
__device__ __forceinline__ void xcd_barrier_complete(unsigned* bar, unsigned x, unsigned& nloc, unsigned& nx) {
    const unsigned G = gridDim.x * gridDim.y * gridDim.z;
    unsigned sum, cnt, mine, sp = 0u;
    for (;;) {
        sum = 0u; cnt = 0u; mine = 0u;
#pragma unroll
        for (unsigned j = 0; j < 16; ++j) { const unsigned c = xb_ld(&bar[XB_XCNT(j)]); sum += c; cnt += (c > 0u) ? 1u : 0u; mine = (j == x) ? c : mine; }
        if (sum == G) break;
        __builtin_amdgcn_s_sleep(1);
        if ((++sp & 255u) == 0u) { if (xb_ld(&bar[XB_TMO])) break; if (sp > XB_SPIN_CAP) { atomicAdd(&bar[XB_TMO], 1u); break; } }
    }
    nloc = mine > 0u ? mine : 1u; nx = cnt > 0u ? cnt : 1u;
}

__device__ __forceinline__ void xcd_barrier(const XcdBarrier& b) {
    asm volatile("s_waitcnt vmcnt(0)" ::: "memory");
    __syncthreads();
    if (threadIdx.x == 0) {
        unsigned* bar = b.bar;
        __builtin_amdgcn_s_waitcnt(0);
        unsigned nloc = b.st[0], nx = b.st[1];
        if (nloc == 0u) { xcd_barrier_complete(bar, b.x, nloc, nx); b.st[0] = nloc; b.st[1] = nx; }
        const unsigned old = xb_add(&bar[XB_XSUB(b.x)], 1u);
        const unsigned gen = old / nloc;
        if (old + 1u == (gen + 1u) * nloc) {
            __builtin_amdgcn_fence(__ATOMIC_RELEASE, "agent");
            asm volatile("s_waitcnt vmcnt(0)" ::: "memory");
            const unsigned og = xb_add(&bar[XB_TOP], 1u);
            const unsigned tg = og / nx;
            if (og + 1u == (tg + 1u) * nx) xb_add(&bar[XB_TOPGEN], 1u);
            else XB_SPIN(xb_ld(&bar[XB_TOPGEN]) == tg, bar);
            __builtin_amdgcn_fence(__ATOMIC_ACQUIRE, "agent");
            xb_add(&bar[XB_XGEN(b.x)], 1u);
            asm volatile("s_waitcnt vmcnt(0)" ::: "memory");
        } else {
            XB_SPIN(xb_ld(&bar[XB_XGEN(b.x)]) == gen, bar);
            __builtin_amdgcn_fence(__ATOMIC_ACQUIRE, "agent");
            asm volatile("s_waitcnt vmcnt(0)" ::: "memory");
        }
    }
    __syncthreads();
}


__device__ __forceinline__ int otid() { int t = threadIdx.x; asm volatile("" : "+v"(t)); return t; }
__device__ __forceinline__ float wave_sum(float v) {
#pragma unroll
    for (int o = 1; o < 64; o <<= 1) v += __shfl_xor(v, o);
    return v;
}
__device__ __forceinline__ void transpose_item(const float* W, int N, const float* gain, bf16_t* WT, int ldk, int koff, int drow0, int k0, int n0, LAS float* scr, int lane) {
    const f32x4* src = (const f32x4*)(W + (size_t)(k0 + lane) * N + n0);
    f32x4 v[8];
#pragma unroll
    for (int j = 0; j < 8; ++j) v[j] = src[j];
    const float gsc = gain ? gain[k0 + lane] : 1.0f;
#pragma unroll
    for (int j = 0; j < 8; ++j) { scr[lane * 33 + 4 * j + 0] = v[j].x * gsc; scr[lane * 33 + 4 * j + 1] = v[j].y * gsc; scr[lane * 33 + 4 * j + 2] = v[j].z * gsc; scr[lane * 33 + 4 * j + 3] = v[j].w * gsc; }
    asm volatile("s_waitcnt lgkmcnt(0)" ::: "memory");
    const int c = lane & 7;
#pragma unroll
    for (int j = 0; j < 4; ++j) { const int n = (lane >> 3) + 8 * j; const LAS float* sp = scr + (8 * c) * 33 + n;
        u32x4 o; o.x = pk2(sp[0 * 33], sp[1 * 33]); o.y = pk2(sp[2 * 33], sp[3 * 33]); o.z = pk2(sp[4 * 33], sp[5 * 33]); o.w = pk2(sp[6 * 33], sp[7 * 33]);
        *(u32x4*)(WT + tiled_off(wslot(drow0 + n), koff + k0 + 8 * c, ldk >> 6)) = o; }
    asm volatile("s_waitcnt lgkmcnt(0)" ::: "memory");
}

struct Params {
    const float* in[18];
    float* out;
    unsigned char* ws;
};

__device__ __forceinline__ void norm_rows_bf16(const float* src, bf16_t* dst, int gw, int ngw, int lane) {
    for (int m = 2 * gw; m < MTOK; m += 2 * ngw) {
        const f32x4* xr = (const f32x4*)(src + (size_t)m * DM) + lane;
        f32x4 v[2][4]; float s0 = 0.f, s1 = 0.f;
#pragma unroll
        for (int j = 0; j < 4; ++j) { v[0][j] = xr[64 * j]; v[1][j] = xr[256 + 64 * j]; }
#pragma unroll
        for (int j = 0; j < 4; ++j) { s0 += (v[0][j].x * v[0][j].x + v[0][j].y * v[0][j].y) + (v[0][j].z * v[0][j].z + v[0][j].w * v[0][j].w);
                                      s1 += (v[1][j].x * v[1][j].x + v[1][j].y * v[1][j].y) + (v[1][j].z * v[1][j].z + v[1][j].w * v[1][j].w); }
        const float r0 = 1.0f / sqrtf(wave_sum(s0) * (1.0f / DM) + EPS), r1 = 1.0f / sqrtf(wave_sum(s1) * (1.0f / DM) + EPS);
#pragma unroll
        for (int j = 0; j < 4; ++j) { u32x2 w; w.x = pk2(v[0][j].x * r0, v[0][j].y * r0); w.y = pk2(v[0][j].z * r0, v[0][j].w * r0); *(u32x2*)(dst + tiled_off(m, 4 * lane + 256 * j, DM / 64)) = w;
                                      u32x2 w1; w1.x = pk2(v[1][j].x * r1, v[1][j].y * r1); w1.y = pk2(v[1][j].z * r1, v[1][j].w * r1); *(u32x2*)(dst + tiled_off(m + 1, 4 * lane + 256 * j, DM / 64)) = w1; }
    }
}
__device__ __forceinline__ void rowscale_phase(const float* ssq, float* rs, int gtid, int nth) {
    for (int row = gtid; row < MTOK; row += nth) {
        const f32x4* pp = (const f32x4*)(ssq + (size_t)row * 16);
        const f32x4 a = pp[0], b = pp[1], c = pp[2], d = pp[3];
        const float sum = ((a.x + a.y) + (a.z + a.w)) + ((b.x + b.y) + (b.z + b.w)) + ((c.x + c.y) + (c.z + c.w)) + ((d.x + d.y) + (d.z + d.w));
        rs[row] = 1.0f / sqrtf(sum * (1.0f / DM) + EPS);
    }
}

__device__ __forceinline__ void attn_load_block(LAS unsigned char* lds, const bf16_t* kp0, const bf16_t* vp0, int kvld, int tokbase, int d, int blk, int tid) {
    const int ch = tid & 7, rw = tid >> 3;
    u32x4 tmp[8];
#pragma unroll
    for (int i = 0; i < 8; ++i) { const int mat = i >> 1, row = rw + 64 * (i & 1); const int tok = tokbase + d * (blk * 128 + row);
        tmp[i] = *(const u32x4*)(((mat < 2) ? kp0 : vp0) + (size_t)tok * kvld + (mat & 1) * 64 + ch * 8); }
#pragma unroll
    for (int i = 0; i < 8; ++i) { const int mat = i >> 1, row = (blk & 1) * 128 + rw + 64 * (i & 1); *(LAS u32x4*)(lds + mat * 36864 + row * 144 + ch * 16) = tmp[i]; }
}
#define ATT_BAR() do { asm volatile("s_waitcnt lgkmcnt(0)" ::: "memory"); __builtin_amdgcn_s_barrier(); asm volatile("" ::: "memory"); } while (0)
__device__ __forceinline__ void attn_phase(LAS unsigned char* lds, bf16_t* Z, bf16_t* YAB, float* LSE, const float* lutg, const float* sinks, int G, int wg) {
    int tid_o = threadIdx.x; asm volatile("" : "+v"(tid_o));
    const int tid = tid_o, wv = __builtin_amdgcn_readfirstlane(tid >> 6), lane = tid & 63, r = lane & 31, h = lane >> 5;
    LAS float* lutl = (LAS float*)(lds + 147456);
    for (int sid = wg; sid < 1792; sid += G) {
        int isB, gi, d, hp, bt, rs, b0, len;
        if (sid < 256) { isB = 0; gi = 0; d = 1; const int chain = sid >> 2; hp = chain & 1; bt = chain >> 1; rs = 0; b0 = (sid & 3) * 4; len = 4; }
        else if (sid < 512) { const int c = sid - 256; isB = 0; gi = 1; d = 4; hp = c & 1; const int seq = c >> 1; bt = seq >> 2; rs = seq & 3; b0 = 0; len = 4; }
        else if (sid < 1536) { const int c = sid - 512; isB = 0; gi = 2; d = 16; hp = c & 1; const int seq = c >> 1; bt = seq >> 4; rs = seq & 15; b0 = 0; len = 1; }
        else { const int c = sid - 1536; isB = 1; gi = 0; d = 1; hp = 0; bt = c >> 3; rs = 0; b0 = (c & 7) * 2; len = 2; }
        const int tokbase = bt * SEQ + rs;
        const bf16_t* kp0 = isB ? (Z + ZO_KVB) : (Z + ZO_KA + (4 * gi + 2 * hp) * 64); const bf16_t* vp0 = isB ? (Z + ZO_KVB + 128) : (Z + ZO_VA + (4 * gi + 2 * hp) * 64);
        const int kvld = isB ? 256 : 768, qld = isB ? 512 : 768;
        for (int b = b0; b < b0 + len; ++b) {
        ATT_BAR();
        if (b == b0) {
            if (b0 > 0) attn_load_block(lds, kp0, vp0, kvld, tokbase, d, b0 - 1, tid);
            const int nh = isB ? 8 : 2, headbase = isB ? 12 : 4 * gi + 2 * hp;
            for (int idx = tid; idx < nh * LUTP; idx += 512) lutl[idx] = lutg[headbase * LUTP + idx];
        }
        attn_load_block(lds, kp0, vp0, kvld, tokbase, d, b, tid);
        ATT_BAR();
        const int nrounds = isB ? 4 : 1;
        for (int rd = 0; rd < nrounds; ++rd) {
            int slot, rt, qcol, lh, qh = 0; float sink = NEGBIG;
            if (!isB) { slot = wv >> 2; rt = wv & 3; qcol = (4 * gi + 2 * hp + slot) * 64; lh = slot; }
            else { const int tk = rd * 8 + wv; qh = tk >> 2; rt = tk & 3; slot = qh >> 2; qcol = qh * 64; lh = qh; sink = sinks[qh] * LOG2E; }
            bf16_t* qbase = Z + (isB ? ZO_QB : ZO_QA) + qcol;
            const int qi = 32 * rt + r;
            const size_t qtok = (size_t)(tokbase + d * (b * 128 + qi));
            const bf16_t* qp = qbase + qtok * qld + 8 * h;
            bf16x8 qf[4];
#pragma unroll
            for (int s = 0; s < 4; ++s) qf[s] = *(const bf16x8*)(qp + 16 * s);
            const LAS unsigned char* Ks = lds + slot * 36864;
            const LAS unsigned char* Vs = lds + 73728 + slot * 36864;
            const int dk_start = (b == 0) ? ((4 - rt) > 0 ? (4 - rt) : 0) : 0;
            f32x16 X[5];
            if (dk_start == 0) {
#pragma unroll
                for (int dk = 0; dk < 5; ++dk) {
                    const LAS float* lp = lutl + lh * LUTP + 32 + 128 - 32 * dk + r - 4 * h;
#pragma unroll
                    for (int i = 0; i < 16; ++i) X[dk][i] = lp[-((i & 3) + 8 * (i >> 2))];
                }
#pragma unroll
                for (int s = 0; s < 4; ++s) {
                    bf16x8 kf[5];
#pragma unroll
                    for (int dk = 0; dk < 5; ++dk) { const int kt = rt + dk; const int lrow = (((b - 1 + (kt >> 2)) & 1) << 7) + ((kt & 3) << 5);
                        kf[dk] = *(const LAS bf16x8*)(Ks + (lrow + r) * 144 + 16 * h + 32 * s); }
#pragma unroll
                    for (int dk = 0; dk < 5; ++dk) X[dk] = __builtin_amdgcn_mfma_f32_32x32x16_bf16(kf[dk], qf[s], X[dk], 0, 0, 0);
                }
            } else {
#pragma unroll
            for (int dk = 0; dk < 5; ++dk) {
                if (dk >= dk_start) {
                    const int kt = rt + dk;
                    const int lrow = (((b - 1 + (kt >> 2)) & 1) << 7) + ((kt & 3) << 5);
                    const LAS unsigned char* kp = Ks + (lrow + r) * 144 + 16 * h;
                    const LAS float* lp = lutl + lh * LUTP + 32 + 128 - 32 * dk + r - 4 * h;
                    f32x16 x;
#pragma unroll
                    for (int i = 0; i < 16; ++i) x[i] = lp[-((i & 3) + 8 * (i >> 2))];
                    bf16x8 kf[4];
#pragma unroll
                    for (int s = 0; s < 4; ++s) kf[s] = *(const LAS bf16x8*)(kp + 32 * s);
#pragma unroll
                    for (int s = 0; s < 4; ++s) x = __builtin_amdgcn_mfma_f32_32x32x16_bf16(kf[s], qf[s], x, 0, 0, 0);
                    X[dk] = x;
                } else {
#pragma unroll
                    for (int i = 0; i < 16; ++i) X[dk][i] = NEGBIG;
                }
            }
            }
            float mxp[4] = {NEGBIG, NEGBIG, NEGBIG, NEGBIG};
#pragma unroll
            for (int dk = 0; dk < 5; ++dk)
#pragma unroll
                for (int i = 0; i < 16; ++i) mxp[i & 3] = fmaxf(mxp[i & 3], X[dk][i]);
            float mx = fmaxf(fmaxf(mxp[0], mxp[1]), fmaxf(mxp[2], mxp[3]));
            mx = fmaxf(mx, __shfl_xor(mx, 32));
            mx = fmaxf(mx, sink);
            float lp4[4] = {0.f, 0.f, 0.f, 0.f};
#pragma unroll
            for (int dk = 0; dk < 5; ++dk)
#pragma unroll
                for (int i = 0; i < 16; ++i) { const float p = __builtin_amdgcn_exp2f(X[dk][i] - mx); X[dk][i] = p; lp4[i & 3] += p; }
            float l = (lp4[0] + lp4[1]) + (lp4[2] + lp4[3]);
            l += __shfl_xor(l, 32);
            if (isB) l += __builtin_amdgcn_exp2f(sink - mx);
            f32x16 O[2];
#pragma unroll
            for (int i = 0; i < 16; ++i) { O[0][i] = 0.f; O[1][i] = 0.f; }
            const int i16 = lane & 15, tq = i16 >> 2, tp = i16 & 3;
            const LAS unsigned char* vbase = Vs + (4 * h + tq) * 144 + 32 * ((lane >> 4) & 1) + 8 * tp;
#pragma unroll
            for (int dk = 0; dk < 5; ++dk) {
                if (dk >= dk_start) {
                    const int kt = rt + dk;
                    const int lrow = (((b - 1 + (kt >> 2)) & 1) << 7) + ((kt & 3) << 5);
#pragma unroll
                    for (int s = 0; s < 2; ++s) {
                        u32x4 pw; pw.x = pk2(X[dk][8 * s + 0], X[dk][8 * s + 1]); pw.y = pk2(X[dk][8 * s + 2], X[dk][8 * s + 3]); pw.z = pk2(X[dk][8 * s + 4], X[dk][8 * s + 5]); pw.w = pk2(X[dk][8 * s + 6], X[dk][8 * s + 7]);
                        const bf16x8 pf = __builtin_bit_cast(bf16x8, pw);
#pragma unroll
                        for (int dt = 0; dt < 2; ++dt) {
                            const LAS unsigned char* va = vbase + (lrow + 16 * s) * 144 + 64 * dt;
                            const s16x4 lo = __builtin_amdgcn_ds_read_tr16_b64_v4i16((LAS s16x4*)(va));
                            const s16x4 hi = __builtin_amdgcn_ds_read_tr16_b64_v4i16((LAS s16x4*)(va + 8 * 144));
                            const bf16x8 vf = __builtin_shufflevector(lo, hi, 0, 1, 2, 3, 4, 5, 6, 7);
                            O[dt] = __builtin_amdgcn_mfma_f32_32x32x16_bf16(vf, pf, O[dt], 0, 0, 0);
                        }
                    }
                }
            }
            const float inv = 1.0f / l;
            bf16_t* op = qbase + qtok * qld;
#pragma unroll
            for (int dt = 0; dt < 2; ++dt)
#pragma unroll
                for (int pr = 0; pr < 2; ++pr) {
                    const int ga = 2 * pr, gb = 2 * pr + 1;
                    const unsigned x0 = pk2(O[dt][4 * ga] * inv, O[dt][4 * ga + 1] * inv), x1 = pk2(O[dt][4 * ga + 2] * inv, O[dt][4 * ga + 3] * inv);
                    const unsigned y0 = pk2(O[dt][4 * gb] * inv, O[dt][4 * gb + 1] * inv), y1 = pk2(O[dt][4 * gb + 2] * inv, O[dt][4 * gb + 3] * inv);
                    const u32x2 s0 = __builtin_amdgcn_permlane32_swap(x0, y0, false, false), s1 = __builtin_amdgcn_permlane32_swap(x1, y1, false, false);
                    u32x4 w; w.x = s0.x; w.y = s1.x; w.z = s0.y; w.w = s1.y;
                    if (isB) *(u32x4*)(YAB + tiled_off((int)qtok, 256 + qcol + 32 * dt + 8 * (2 * pr + h), 12)) = w;
                    else *(u32x4*)(op + 32 * dt + 8 * (2 * pr + h)) = w;
                }
            if (!isB && h == 0) LSE[((size_t)gi * MTOK + qtok) * 4 + 2 * hp + slot] = mx + __builtin_amdgcn_logf(l);
        }
        }
    }
}

__device__ __forceinline__ void combine_phase(const bf16_t* Z, const float* LSE, bf16_t* YAB, int gtid, int nth) {
    for (int idx = gtid; idx < MTOK * 32; idx += nth) {
        const int tok = idx >> 5; const int c = (int)(idx & 31), s = c >> 3, e0 = (c & 7) * 8;
        const float l0 = LSE[((size_t)0 * MTOK + tok) * 4 + s], l1 = LSE[((size_t)1 * MTOK + tok) * 4 + s], l2 = LSE[((size_t)2 * MTOK + tok) * 4 + s];
        const float mx = fmaxf(l0, fmaxf(l1, l2));
        const float w0 = __builtin_amdgcn_exp2f(l0 - mx), w1 = __builtin_amdgcn_exp2f(l1 - mx), w2 = __builtin_amdgcn_exp2f(l2 - mx);
        const float inv = 1.0f / (w0 + w1 + w2);
        const float a0 = w0 * inv, a1 = w1 * inv, a2 = w2 * inv;
        const bf16_t* zr = Z + ZO_QA + (size_t)tok * 768 + s * 64 + e0;
        const u32x4 o0 = *(const u32x4*)(zr), o1 = *(const u32x4*)(zr + 256), o2 = *(const u32x4*)(zr + 512);
        u32x4 w;
#pragma unroll
        for (int q = 0; q < 4; ++q) {
            const float lo = a0 * bf_lo(o0[q]) + a1 * bf_lo(o1[q]) + a2 * bf_lo(o2[q]);
            const float hi = a0 * bf_hi(o0[q]) + a1 * bf_hi(o1[q]) + a2 * bf_hi(o2[q]);
            w[q] = pk2(lo, hi);
        }
        *(u32x4*)(YAB + tiled_off(tok, s * 64 + e0, 12)) = w;
    }
}

#ifndef DBG_A
#define DBG_A -1
#endif
#ifndef DBG_B
#define DBG_B -1
#endif
#ifndef DBG_DOUBLE
#define DBG_DOUBLE -1
#endif
#ifndef DBG_GEMM_PHASE
#define DBG_GEMM_PHASE -1
#endif
#define GDBG(k) ((DBG_GEMM_PHASE == (k)) ? (unsigned long long*)(p.ws + MiB) + 20 : (unsigned long long*)nullptr)
#define REP(k) for (int rep_ = 0; rep_ < ((DBG_DOUBLE == (k)) ? 2 : 1); ++rep_)
#define TSTAMP(k) do { if (DBG_A >= 0 && wg == 0 && threadIdx.x == 0) { ((unsigned long long*)(p.ws + MiB))[k] = __builtin_amdgcn_s_memrealtime(); ((unsigned long long*)(p.ws + MiB))[32 + k] = __builtin_amdgcn_s_memtime(); } } while (0)
#ifndef PHASE_MASK
#define PHASE_MASK 0xFFFFu
#endif
#define PH(k) ((PHASE_MASK >> (k)) & 1u)

__global__ void __launch_bounds__(512, 2) fwd_kernel(Params p) {
    extern __shared__ __attribute__((aligned(16))) unsigned char lds_raw[];
    LAS unsigned char* lds = (LAS unsigned char*)lds_raw;
    cg::grid_group grid = cg::this_grid();
    const int G = gridDim.x, wg = blockIdx.x, ngw = G * 8;
    if (threadIdx.x < 16) ((LAS unsigned*)(lds + LDS_CTL_OFF))[threadIdx.x] = 0u;
    __syncthreads();
    const XcdBarrier xbar = xcd_barrier_post((unsigned*)p.ws, (volatile LAS unsigned*)(lds + LDS_CTL_OFF));
#define PHASE_IDS const int tid = otid(), lane = tid & 63, wave = __builtin_amdgcn_readfirstlane(tid >> 6), gw = wg * 8 + wave; (void)lane; (void)gw;
#define Wgu1 ((bf16_t*)(p.ws + WS_WGU1))
#define Wd1 ((bf16_t*)(p.ws + WS_WD1))
#define Win ((bf16_t*)(p.ws + WS_WIN))
#define Wbr ((bf16_t*)(p.ws + WS_WBR))
#define Wout ((bf16_t*)(p.ws + WS_WOUT))
#define Wgu2 ((bf16_t*)(p.ws + WS_WGU2))
#define Wd2 ((bf16_t*)(p.ws + WS_WD2))
#define lutg ((float*)(p.ws + WS_LUT))
#define LSE ((float*)(p.ws + WS_LSE))
#define XN ((bf16_t*)(p.ws + WS_XN))
#define HB ((bf16_t*)(p.ws + WS_HB))
#define RS ((float*)(p.ws + WS_RS))
#define SSQ ((float*)(p.ws + WS_SSQ))
#define YAB ((bf16_t*)(p.ws + WS_XN))
#define Z ((bf16_t*)(p.ws + WS_Z))
#define HID ((bf16_t*)(p.ws + WS_Z))

    TSTAMP(0);
#ifdef DBG_XCC
    if (wg == 0 && threadIdx.x == 0) *((unsigned*)(p.ws + MiB + 4096)) = 0u;
#endif
    REP(0) if (PH(0)) {
        PHASE_IDS
        LAS float* scr = (LAS float*)(lds + wave * 16384);
        constexpr int I_GU = 16 * 88, I_DN = 44 * 32, I_IN = 16 * 160, I_BA = 4 * 32, I_BB = 8 * 32, I_OUT = 16 * 32;
        constexpr int NITEMS = 6 * I_GU + I_IN + I_BA + I_BB + I_OUT;
        for (int it = gw; it < NITEMS; it += ngw) {
            int rr = it;
            bool done = false;
#pragma unroll
            for (int f = 0; f < 4; ++f) {
                if (!done && rr < I_GU) { const int kb = rr / 88, nb = rr % 88, n0 = nb * 32; const int which = f & 1, layer = f >> 1;
                    const float* W = p.in[layer ? (which ? 15 : 14) : (which ? 3 : 2)]; const float* gain = p.in[layer ? 13 : 1];
                    transpose_item(W, DFF, gain, layer ? Wgu2 : Wgu1, DM, 0, (n0 / 128) * 256 + which * 128 + (n0 % 128), kb * 64, n0, scr, lane); done = true; }
                if (!done) rr -= I_GU;
            }
            if (done) continue;
            if (rr < I_DN) { transpose_item(p.in[4], DM, nullptr, Wd1, DFF, 0, (rr % 32) * 32, (rr / 32) * 64, (rr % 32) * 32, scr, lane); continue; } rr -= I_DN;
            if (rr < I_DN) { transpose_item(p.in[16], DM, nullptr, Wd2, DFF, 0, (rr % 32) * 32, (rr / 32) * 64, (rr % 32) * 32, scr, lane); continue; } rr -= I_DN;
            if (rr < I_IN) { transpose_item(p.in[6], DIN, p.in[5], Win, DM, 0, (rr % 160) * 32, (rr / 160) * 64, (rr % 160) * 32, scr, lane); continue; } rr -= I_IN;
            if (rr < I_BA) { transpose_item(p.in[8], DM, nullptr, Wbr, 768, 0, (rr % 32) * 32, (rr / 32) * 64, (rr % 32) * 32, scr, lane); continue; } rr -= I_BA;
            if (rr < I_BB) { transpose_item(p.in[9], DM, nullptr, Wbr, 768, 256, (rr % 32) * 32, (rr / 32) * 64, (rr % 32) * 32, scr, lane); continue; } rr -= I_BB;
            transpose_item(p.in[10], DM, nullptr, Wout, DM, 0, (rr % 32) * 32, (rr / 32) * 64, (rr % 32) * 32, scr, lane);
        }
        if (wg == 0) {
            const float* rel = p.in[12];
            for (int idx = tid; idx < 20 * LUTP; idx += 512) {
                const int hd = idx / LUTP, dist = idx % LUTP - 32;
                const int dil = (hd < 4) ? 1 : ((hd < 8) ? 4 : ((hd < 12) ? 16 : 1));
                const int maxs = (hd < 12) ? 128 : 127;
                float v = NEGBIG;
                if (dist >= 0 && dist <= maxs) {
                    const int n = dist * dil; int bucket;
                    if (n < 16) bucket = n;
                    else { const float nf = (float)n; int lg = 16 + (int)(logf(nf / 16.0f) / 4.852030263919617f * 16.0f); bucket = lg < 31 ? lg : 31; }
                    v = rel[bucket * 20 + hd] * LOG2E;
                }
                lutg[idx] = v;
            }
        }
        norm_rows_bf16(p.in[0], XN, gw, ngw, lane);
    }
    if (G > (1 << 24)) grid.sync();
    xcd_barrier(xbar); TSTAMP(1);
#ifdef DBG_XCC
    if (threadIdx.x == 0) { const unsigned xcc = (unsigned)__builtin_amdgcn_s_getreg((3 << 11) | 20) & 0xFu; if (xcc != (unsigned)(wg & 7)) atomicAdd((unsigned*)(p.ws + MiB + 4096), 1u); }
#endif
    REP(1) if (PH(1)) { pg8::Gemm g{XN, Wgu1, MTOK, 2 * DFF, DM, DM, 1, GDBG(1)}; pg8::StaticOrder S; S.init(MTOK, 2 * DFF, G, wg); pg8::EpiSwiGLU E{HID, nullptr}; pg8::gemm_phase<pg8::EpiSwiGLU, (DBG_GEMM_PHASE == 1)>(lds, g, S, E); }
    xcd_barrier(xbar); TSTAMP(2);
    REP(2) if (PH(2)) { pg8::Gemm g{HID, Wd1, MTOK, DM, DFF, DFF, 1, GDBG(2)}; pg8::StaticOrder S; S.init(MTOK, DM, G, wg); pg8::EpiHB<true> E{p.in[0], HB, SSQ, 0.5f}; pg8::gemm_phase<pg8::EpiHB<true>, (DBG_GEMM_PHASE == 2)>(lds, g, S, E); }
    xcd_barrier(xbar); TSTAMP(3);
    REP(3) if (PH(3)) rowscale_phase(SSQ, RS, wg * 512 + otid(), G * 512);
    xcd_barrier(xbar); TSTAMP(4);
    REP(4) if (PH(4)) { pg8::Gemm g{HB, Win, MTOK, DIN, DM, DM, 1, GDBG(4)}; pg8::StaticOrder S; S.init(MTOK, DIN, G, wg); pg8::EpiZ E{Z, p.in[7], RS}; pg8::gemm_phase<pg8::EpiZ, (DBG_GEMM_PHASE == 4)>(lds, g, S, E); }
    xcd_barrier(xbar); TSTAMP(5);
    REP(5) if (PH(5)) attn_phase(lds, Z, YAB, LSE, lutg, p.in[11], G, wg);
    xcd_barrier(xbar); TSTAMP(6);
    REP(6) if (PH(6)) combine_phase(Z, LSE, YAB, wg * 512 + otid(), G * 512);
    xcd_barrier(xbar); TSTAMP(7);
    REP(7) if (PH(7)) { pg8::Gemm g{YAB, Wbr, MTOK, DM, 768, 768, 1, GDBG(7)}; pg8::StaticOrder S; S.init(MTOK, DM, G, wg); pg8::EpiMerge E{Z + ZO_KA, Z}; pg8::gemm_phase<pg8::EpiMerge, (DBG_GEMM_PHASE == 7)>(lds, g, S, E); }
    xcd_barrier(xbar); TSTAMP(8);
    REP(8) if (PH(8)) { pg8::Gemm g{Z + ZO_KA, Wout, MTOK, DM, DM, DM, 1, GDBG(8)}; pg8::StaticOrder S; S.init(MTOK, DM, G, wg); pg8::EpiHB<false> E{nullptr, HB, SSQ, 1.0f}; pg8::gemm_phase<pg8::EpiHB<false>, (DBG_GEMM_PHASE == 8)>(lds, g, S, E); }
    xcd_barrier(xbar); TSTAMP(9);
    REP(9) if (PH(9)) rowscale_phase(SSQ, RS, wg * 512 + otid(), G * 512);
    xcd_barrier(xbar); TSTAMP(10);
    REP(10) if (PH(10)) { pg8::Gemm g{HB, Wgu2, MTOK, 2 * DFF, DM, DM, 1, GDBG(10)}; pg8::StaticOrder S; S.init(MTOK, 2 * DFF, G, wg); pg8::EpiSwiGLU E{HID, RS}; pg8::gemm_phase<pg8::EpiSwiGLU, (DBG_GEMM_PHASE == 10)>(lds, g, S, E); }
    xcd_barrier(xbar); TSTAMP(11);
    REP(11) if (PH(11)) { pg8::Gemm g{HID, Wd2, MTOK, DM, DFF, DFF, 1, GDBG(11)}; pg8::StaticOrder S; S.init(MTOK, DM, G, wg); pg8::EpiHB<false> E{nullptr, HB, SSQ, 0.5f}; pg8::gemm_phase<pg8::EpiHB<false>, (DBG_GEMM_PHASE == 11)>(lds, g, S, E); }
    xcd_barrier(xbar); TSTAMP(12);
    REP(12) if (PH(12)) {
        PHASE_IDS
        const float* gf = p.in[17];
        f32x4 gv[4];
#pragma unroll
        for (int j = 0; j < 4; ++j) gv[j] = *((const f32x4*)gf + lane + 64 * j);
        for (int m = 2 * gw; m < MTOK; m += 2 * ngw) {
            u32x2 hv[2][4]; float ps[2];
#pragma unroll
            for (int q = 0; q < 2; ++q) {
#pragma unroll
                for (int j = 0; j < 4; ++j) hv[q][j] = *(const u32x2*)(HB + tiled_off(m + q, 4 * lane + 256 * j, DM / 64));
                ps[q] = SSQ[(size_t)(m + q) * 16 + (lane & 15)];
            }
#pragma unroll
            for (int q = 0; q < 2; ++q) {
                float sum = ps[q];
#pragma unroll
                for (int o = 1; o < 16; o <<= 1) sum += __shfl_xor(sum, o);
                const float r = 1.0f / sqrtf(sum * (1.0f / DM) + EPS);
                f32x4* orow = (f32x4*)(p.out + (size_t)(m + q) * DM) + lane;
#pragma unroll
                for (int j = 0; j < 4; ++j) { const u32x2 a = hv[q][j]; orow[64 * j] = (f32x4){bf_lo(a.x), bf_hi(a.x), bf_lo(a.y), bf_hi(a.y)} * r * gv[j]; }
            }
        }
    }
    if (DBG_A >= 0) {
        grid.sync();
        if (wg == 0) { const unsigned long long* tsp = (const unsigned long long*)(p.ws + MiB);
#ifdef DBG_XCC
            const long n = 100 + 10 * (long)(*((const unsigned*)(p.ws + MiB + 4096)));
#else
#ifdef DBG_CLOCK
            const long n = (long)((tsp[32 + DBG_B] - tsp[32 + DBG_A]) * 100 / (tsp[DBG_B] - tsp[DBG_A]));
#else
            const long n = DBG_GEMM_MODE ? (long)(tsp[20] / 10) : (long)(tsp[DBG_B >= 0 ? DBG_B : 0] - tsp[DBG_A >= 0 ? DBG_A : 0]) / 10;
#endif
#endif

            for (long i = threadIdx.x; i < n; i += 512) p.out[(size_t)i * 997 + 3] += 0.1f; }
    }
}

#undef Z
#undef XN
#undef HB
#undef RS
#undef SSQ
#undef YAB
#undef HID
#undef LSE
#undef lutg
extern "C" void kernel_launch(void* const* d_in, const int* in_sizes, int n_in, void* d_out, int out_size, void* d_ws, size_t ws_size, hipStream_t stream) {
    static int grid = 0;
    if (grid == 0) {
        if (n_in != 18 || out_size != MTOK * DM || ws_size < WS_END) { fprintf(stderr, "kernel_launch: unexpected shapes (n_in %d out %d ws %zu)\n", n_in, out_size, ws_size); grid = -1; return; }
        int dev = 0, cus = 0, per_cu = 0;
        if (hipGetDevice(&dev) != hipSuccess || hipDeviceGetAttribute(&cus, hipDeviceAttributeMultiprocessorCount, dev) != hipSuccess) { grid = -1; return; }
        if (hipFuncSetAttribute((const void*)fwd_kernel, hipFuncAttributeMaxDynamicSharedMemorySize, LDS_BYTES) != hipSuccess) { fprintf(stderr, "hipFuncSetAttribute failed\n"); grid = -1; return; }
        if (hipOccupancyMaxActiveBlocksPerMultiprocessor(&per_cu, (const void*)fwd_kernel, 512, LDS_BYTES) != hipSuccess || per_cu < 1) per_cu = 1;
        (void)hipGetLastError();
        grid = cus * per_cu;
    }
    if (grid < 0) return;
    if (hipMemsetAsync(d_ws, 0, XCD_BAR_WORDS * 4, stream) != hipSuccess) { fprintf(stderr, "memset failed\n"); return; }
    Params p{};
    for (int i = 0; i < 18; ++i) p.in[i] = (const float*)d_in[i];
    p.out = (float*)d_out; p.ws = (unsigned char*)d_ws;
    void* args[] = {&p};
    hipError_t e = hipLaunchCooperativeKernel((const void*)fwd_kernel, dim3(grid), dim3(512), args, LDS_BYTES, stream);
    if (e != hipSuccess) fprintf(stderr, "cooperative launch failed: %s (grid %d)\n", hipGetErrorString(e), grid);
}
```

```cpp
#include <hip/hip_runtime.h>
#include <hip/hip_cooperative_groups.h>
#include <cstdio>
namespace cg = cooperative_groups;

#define LAS __attribute__((address_space(3)))
typedef unsigned short bf16_t;
typedef short bf16x8 __attribute__((ext_vector_type(8)));
typedef short s16x4 __attribute__((ext_vector_type(4)));
typedef float f32x4 __attribute__((ext_vector_type(4)));
typedef float f32x2 __attribute__((ext_vector_type(2)));
typedef float f32x16 __attribute__((ext_vector_type(16)));
typedef unsigned u32x4 __attribute__((ext_vector_type(4)));
typedef unsigned u32x2 __attribute__((ext_vector_type(2)));
typedef __bf16 bf16x2v __attribute__((ext_vector_type(2)));

constexpr int MTOK = 65536, DM = 1024, DFF = 2816, DIN = 5120, SEQ = 2048;
constexpr float EPS = 1e-6f, LOG2E = 1.4426950408889634f, QSCALE = 0.125f * 1.4426950408889634f, NEGBIG = -1e30f;
constexpr int ZAQ = 0, ZAK = 768, ZAV = 1536, ZBQ = 2304, ZBK = 2816, ZBV = 2944, ZGA = 3072, ZGB = 4096;
constexpr size_t ZO_KA = 0, ZO_VA = (size_t)MTOK * 768, ZO_QA = (size_t)MTOK * 1536, ZO_QB = (size_t)MTOK * 2304, ZO_KVB = (size_t)MTOK * 2816, ZO_G = (size_t)MTOK * 3072;
constexpr int LUTP = 192;
constexpr int LDS_CTL_OFF = 147456 + 8 * LUTP * 4;
constexpr int LDS_BYTES = LDS_CTL_OFF + 64;

constexpr size_t MiB = 1u << 20;
constexpr size_t WS_WGU1 = 2 * MiB, WS_WD1 = 14 * MiB, WS_WIN = 20 * MiB, WS_WBR = 30 * MiB, WS_WOUT = 32 * MiB, WS_WGU2 = 34 * MiB, WS_WD2 = 46 * MiB;
constexpr size_t WS_LUT = 52 * MiB, WS_LSE = 53 * MiB, WS_RS = 56 * MiB, WS_SSQ = 57 * MiB, WS_XN = 64 * MiB, WS_HB = 192 * MiB, WS_Z = 320 * MiB, WS_END = 960 * MiB;

__device__ __forceinline__ unsigned pk2(float lo, float hi) { f32x2 f = {lo, hi}; return __builtin_bit_cast(unsigned, __builtin_convertvector(f, bf16x2v)); }
__device__ __forceinline__ float bf_lo(unsigned u) { return __uint_as_float(u << 16); }
__device__ __forceinline__ float bf_hi(unsigned u) { return __uint_as_float(u & 0xffff0000u); }
__device__ __forceinline__ float fast_sigmoid(float v) { return __builtin_amdgcn_rcpf(1.0f + __builtin_amdgcn_exp2f(-v * LOG2E)); }

__device__ __forceinline__ size_t tiled_off(int row, int col, int ktiles) {
    const int r = row & 127, c = col & 63;
    const int st = (r >> 4) * 2 + (c >> 5), ob = (r & 15) * 64 + (c & 31) * 2;
    const int byte = st * 1024 + (ob ^ (((ob >> 9) & 1) << 5));
    return ((size_t)(((row >> 8) * ktiles + (col >> 6)) * 2 + ((row >> 7) & 1))) * 8192 + (byte >> 1);
}
__device__ __forceinline__ int wslot(int x) { return (x & ~31) | ((((x >> 2) & 1) << 4) | (((x >> 3) & 3) << 2) | (x & 3)); }
__device__ __forceinline__ const char* uni_ptr(const char* p) { const unsigned long long v = (unsigned long long)p; const unsigned lo = __builtin_amdgcn_readfirstlane((unsigned)v), hi = __builtin_amdgcn_readfirstlane((unsigned)(v >> 32)); return (const char*)(((unsigned long long)hi << 32) | lo); }
namespace pg8 {
constexpr int BM = 256, BK = 64, HALF = 128, HTB = HALF * BK * 2, STAGE_BYTES = 8 * HTB, NXCD = 8, WGM = 8;
__host__ __device__ __forceinline__ int lds_byte(int r, int c) { const int st = (r >> 4) * 2 + (c >> 5), rr = r & 15, cc = c & 31, ob = rr * 64 + cc * 2; return st * 1024 + (ob ^ (((ob >> 9) & 1) << 5)); }
__host__ __device__ __forceinline__ void stage_rc(int b, int& R, int& C) { const int st = b / 1024, sb = b % 1024, swz = sb ^ (((sb >> 9) & 1) << 5); R = (st >> 1) * 16 + swz / 64; C = (st & 1) * 32 + (swz % 64) / 2; }
__host__ __device__ __forceinline__ int perm32(int rho) { const int n = rho >> 4, i = rho & 15; return 8 * (i >> 2) + 4 * n + (i & 3); }
struct Unit { int pm, pn; };
struct Gemm { const bf16_t* A; const bf16_t* Bt; int M, N, K; int lda; int a_tiled; unsigned long long* dbg; };
struct StaticOrder {
    int nM, nN, nwg, G, c;
    __device__ void init(int M, int N, int G_, int c_) { nM = M / BM; nN = N / BM; nwg = nM * nN; G = G_; c = c_; }
    __device__ bool next(int i, Unit& u) const {
        const long L = (long)i * G + c; if (L >= nwg) return false;
        int wgid = (int)L; { const int q = nwg / NXCD, r = nwg % NXCD, xcd = wgid % NXCD, off = wgid / NXCD; wgid = (xcd < r ? xcd * (q + 1) : r * (q + 1) + (xcd - r) * q) + off; }
        const int nig = WGM * nN, gid = wgid / nig, fm = gid * WGM, gsz = (nM - fm) < WGM ? (nM - fm) : WGM;
        u.pm = fm + ((wgid % nig) % gsz); u.pn = (wgid % nig) / gsz; return true;
    }
};

typedef f32x4 Acc[2][2][4][2];

struct EpiSwiGLU {
    static constexpr bool PERM = true; static constexpr int MID_T = -1;
    bf16_t* O; const float* rs;
    __device__ __forceinline__ void mid(Acc&, const Unit&, int, int, int, int) const {}
    __device__ __forceinline__ void operator()(const Acc& acc, const Unit& u, int wr, int wc, int fr, int fq) const {
        int opq; asm volatile("v_mov_b32 %0, 0" : "=v"(opq));
        const int row0 = u.pm * BM + wr * 64 + fr + opq;
        float rsv[2][4];
#pragma unroll
        for (int ai = 0; ai < 2; ++ai)
#pragma unroll
            for (int m = 0; m < 4; ++m) rsv[ai][m] = rs ? rs[row0 + ai * HALF + m * 16] : 1.0f;
#pragma unroll
        for (int ai = 0; ai < 2; ++ai)
#pragma unroll
            for (int m = 0; m < 4; ++m) {
                bf16_t* rowp = O + tiled_off(row0 + ai * HALF + m * 16, u.pn * 128 + wc * 32 + 8 * fq, DFF / 64);
                float hv[8];
#pragma unroll
                for (int n = 0; n < 2; ++n)
#pragma unroll
                    for (int j = 0; j < 4; ++j) { const float g = acc[ai][0][m][n][j] * rsv[ai][m], up = acc[ai][1][m][n][j] * rsv[ai][m]; hv[4 * n + j] = g * fast_sigmoid(g) * up; }
                u32x4 w; w.x = pk2(hv[0], hv[1]); w.y = pk2(hv[2], hv[3]); w.z = pk2(hv[4], hv[5]); w.w = pk2(hv[6], hv[7]);
                *(u32x4*)rowp = w;
            }
    }
};
struct EpiHB {
    static constexpr bool PERM = true; static constexpr int MID_T = -1;
    const bf16_t* src; const float* srcinv; bf16_t* hb; float* ssq; float scale;
    __device__ __forceinline__ void mid(Acc&, const Unit&, int, int, int, int) const {}
    __device__ __forceinline__ void operator()(const Acc& acc, const Unit& u, int wr, int wc, int fr, int fq) const {
        int opq; asm volatile("v_mov_b32 %0, 0" : "=v"(opq));
        const int row0 = u.pm * BM + wr * 64 + fr + opq, col0 = u.pn * BM + wc * 32 + 8 * fq;
#pragma unroll
        for (int ai = 0; ai < 2; ++ai) {
            u32x4 bh[4][2]; float bs[4];
#pragma unroll
            for (int m = 0; m < 4; ++m) {
#pragma unroll
                for (int bj = 0; bj < 2; ++bj) bh[m][bj] = *(const u32x4*)(src + tiled_off(row0 + ai * HALF + m * 16, col0 + bj * HALF, DM / 64));
                bs[m] = srcinv ? srcinv[row0 + ai * HALF + m * 16] : 1.0f;
            }
            asm volatile("" ::: "memory");
#pragma unroll
            for (int m = 0; m < 4; ++m) {
                const float bsc = srcinv ? __builtin_amdgcn_rcpf(bs[m]) : 1.0f;
                float sq = 0.f;
#pragma unroll
                for (int bj = 0; bj < 2; ++bj) {
                    const u32x4 b = bh[m][bj];
                    f32x4 v0 = (f32x4){bf_lo(b.x), bf_hi(b.x), bf_lo(b.y), bf_hi(b.y)} * bsc, v1 = (f32x4){bf_lo(b.z), bf_hi(b.z), bf_lo(b.w), bf_hi(b.w)} * bsc;
                    v0 += acc[ai][bj][m][0] * scale; v1 += acc[ai][bj][m][1] * scale;
                    sq += (v0[0] * v0[0] + v0[1] * v0[1]) + (v0[2] * v0[2] + v0[3] * v0[3]) + (v1[0] * v1[0] + v1[1] * v1[1]) + (v1[2] * v1[2] + v1[3] * v1[3]);
                    u32x4 w; w.x = pk2(v0[0], v0[1]); w.y = pk2(v0[2], v0[3]); w.z = pk2(v1[0], v1[1]); w.w = pk2(v1[2], v1[3]);
                    *(u32x4*)(hb + tiled_off(row0 + ai * HALF + m * 16, col0 + bj * HALF, DM / 64)) = w;
                }
                sq += __shfl_xor(sq, 16); sq += __shfl_xor(sq, 32);
                if (fq == 0) ssq[(size_t)(row0 + ai * HALF + m * 16) * 16 + u.pn * 4 + wc] = sq;
            }
            asm volatile("" ::: "memory");
        }
    }
};
struct EpiZ {
    static constexpr bool PERM = true; static constexpr int MID_T = -1;
    bf16_t* O; const float* bias; const float* rs;
    __device__ __forceinline__ void mid(Acc&, const Unit&, int, int, int, int) const {}
    __device__ __forceinline__ void operator()(const Acc& acc, const Unit& u, int wr, int wc, int fr, int fq) const {
        int opq; asm volatile("v_mov_b32 %0, 0" : "=v"(opq));
        const int row0 = u.pm * BM + wr * 64 + fr + opq, col0 = u.pn * BM + wc * 32 + 8 * fq;
        float rsv[2][4];
#pragma unroll
        for (int ai = 0; ai < 2; ++ai)
#pragma unroll
            for (int m = 0; m < 4; ++m) rsv[ai][m] = rs[row0 + ai * HALF + m * 16];
        const bool isq = (u.pn < 3) || (u.pn == 9) || (u.pn == 10), isg = (u.pn >= 12);
        const int pn = u.pn; size_t bo; int ld, c0;
        if (pn < 3) { bo = ZO_QA; ld = 768; c0 = pn * 256; } else if (pn < 6) { bo = ZO_KA; ld = 768; c0 = (pn - 3) * 256; } else if (pn < 9) { bo = ZO_VA; ld = 768; c0 = (pn - 6) * 256; }
        else if (pn < 11) { bo = ZO_QB; ld = 512; c0 = (pn - 9) * 256; } else if (pn == 11) { bo = ZO_KVB; ld = 256; c0 = 0; } else { bo = ZO_G; ld = 2048; c0 = (pn - 12) * 256; }
        bf16_t* blk = O + bo; const int cb = c0 + wc * 32 + 8 * fq;
        const float sc = isq ? QSCALE : 1.0f;
        f32x4 bv[2][2];
#pragma unroll
        for (int bj = 0; bj < 2; ++bj)
#pragma unroll
            for (int n = 0; n < 2; ++n) bv[bj][n] = *(const f32x4*)(bias + col0 + bj * HALF + 4 * n);
#pragma unroll
        for (int ai = 0; ai < 2; ++ai)
#pragma unroll
            for (int m = 0; m < 4; ++m) {
                bf16_t* rowp = blk + (size_t)(row0 + ai * HALF + m * 16) * ld + cb;
#pragma unroll
                for (int bj = 0; bj < 2; ++bj) {
                    f32x4 v0 = (acc[ai][bj][m][0] * rsv[ai][m] + bv[bj][0]) * sc, v1 = (acc[ai][bj][m][1] * rsv[ai][m] + bv[bj][1]) * sc;
                    if (isg) {
                        unsigned q0 = 0, q1 = 0;
#pragma unroll
                        for (int j = 0; j < 4; ++j) { q0 = __builtin_amdgcn_cvt_pk_u8_f32(fast_sigmoid(v0[j]) * 255.0f, j, q0); q1 = __builtin_amdgcn_cvt_pk_u8_f32(fast_sigmoid(v1[j]) * 255.0f, j, q1); }
                        u32x2 w8; w8.x = q0; w8.y = q1;
                        *(u32x2*)((unsigned char*)(O + ZO_G) + (size_t)(row0 + ai * HALF + m * 16) * 2048 + c0 + wc * 32 + 8 * fq + bj * HALF) = w8;
                        continue;
                    }
                    u32x4 w; w.x = pk2(v0[0], v0[1]); w.y = pk2(v0[2], v0[3]); w.z = pk2(v1[0], v1[1]); w.w = pk2(v1[2], v1[3]);
                    *(u32x4*)(rowp + bj * HALF) = w;
                }
            }
    }
};
struct EpiMerge {
    static constexpr bool PERM = true; static constexpr int MID_T = 2;
    bf16_t* O; const bf16_t* Z;
    __device__ __forceinline__ void mid(Acc& acc, const Unit& u, int wr, int wc, int fr, int fq) const {
        int opq; asm volatile("v_mov_b32 %0, 0" : "=v"(opq));
        const int row0 = u.pm * BM + wr * 64 + fr + opq, col0 = u.pn * BM + wc * 32 + 8 * fq;
        const unsigned char* G8 = (const unsigned char*)(Z + ZO_G);
        u32x2 sa[2][4][2], sb[2][4][2];
#pragma unroll
        for (int ai = 0; ai < 2; ++ai)
#pragma unroll
            for (int m = 0; m < 4; ++m) {
                const unsigned char* zr = G8 + (size_t)(row0 + ai * HALF + m * 16) * 2048 + col0;
#pragma unroll
                for (int bj = 0; bj < 2; ++bj) { sa[ai][m][bj] = *(const u32x2*)(zr + bj * HALF); sb[ai][m][bj] = *(const u32x2*)(zr + 1024 + bj * HALF); }
            }
        asm volatile("" ::: "memory");
#pragma unroll
        for (int ai = 0; ai < 2; ++ai)
#pragma unroll
            for (int m = 0; m < 4; ++m)
#pragma unroll
                for (int bj = 0; bj < 2; ++bj)
#pragma unroll
                    for (int n = 0; n < 2; ++n)
#pragma unroll
                        for (int j = 0; j < 4; ++j) {
                            const float qa = (float)((sa[ai][m][bj][n] >> (8 * j)) & 255u), qb = fmaxf((float)((sb[ai][m][bj][n] >> (8 * j)) & 255u), 0.5f);
                            acc[ai][bj][m][n][j] *= qa * __builtin_amdgcn_rcpf(qb);
                        }
        asm volatile("" : "+v"(acc[0][0][0][0]), "+v"(acc[1][1][3][1]) :: "memory");
    }
    __device__ __forceinline__ void operator()(const Acc& acc, const Unit& u, int wr, int wc, int fr, int fq) const {
        const int row0 = u.pm * BM + wr * 64 + fr, col0 = u.pn * BM + wc * 32 + 8 * fq;
        const unsigned char* G8 = (const unsigned char*)(Z + ZO_G);
        u32x2 sbv[2][4][2];
#pragma unroll
        for (int ai = 0; ai < 2; ++ai)
#pragma unroll
            for (int m = 0; m < 4; ++m) {
                const unsigned char* zr = G8 + (size_t)(row0 + ai * HALF + m * 16) * 2048 + col0;
#pragma unroll
                for (int bj = 0; bj < 2; ++bj) sbv[ai][m][bj] = *(const u32x2*)(zr + 1024 + bj * HALF);
            }
        asm volatile("" ::: "memory");
#pragma unroll
        for (int ai = 0; ai < 2; ++ai)
#pragma unroll
            for (int m = 0; m < 4; ++m) {
                const int orow = row0 + ai * HALF + m * 16;
#pragma unroll
                for (int bj = 0; bj < 2; ++bj) {
                    float o[8];
#pragma unroll
                    for (int n = 0; n < 2; ++n)
#pragma unroll
                        for (int j = 0; j < 4; ++j) o[4 * n + j] = acc[ai][bj][m][n][j] * (fmaxf((float)((sbv[ai][m][bj][n] >> (8 * j)) & 255u), 0.5f) * (1.0f / 255.0f));
                    u32x4 w; w.x = pk2(o[0], o[1]); w.y = pk2(o[2], o[3]); w.z = pk2(o[4], o[5]); w.w = pk2(o[6], o[7]);
                    *(u32x4*)(O + tiled_off(orow, col0 + bj * HALF, DM / 64)) = w;
                }
            }
    }
};

template <class Epi, bool DBGP = false>
__device__ __forceinline__ void gemm_phase(LAS unsigned char* lds, const Gemm g, const StaticOrder& S, const Epi& E) {
    int tid_o = threadIdx.x; asm volatile("" : "+v"(tid_o));
    const int tid = tid_o, wid = __builtin_amdgcn_readfirstlane(tid >> 6), lane = tid & 63, wr = wid >> 2, wc = wid & 3, fr = lane & 15, fq = lane >> 4;
    const int K = g.K, nt = K / BK;
    unsigned voffA[2], voffB[2];
#pragma unroll
    for (int i = 0; i < 2; ++i) { int R, C; stage_rc(tid * 16 + i * 8192, R, C); const int Rb = Epi::PERM ? ((R & ~31) + perm32(R & 31)) : R;
        (void)Rb; voffA[i] = g.a_tiled ? (unsigned)(tid * 16 + i * 8192) : (unsigned)(R * g.lda + C) * 2u; voffB[i] = (unsigned)(tid * 16 + i * 8192); }
    const size_t kstep = (size_t)(BM * BK * 2);
    const size_t hstep = (size_t)(HALF * BK * 2);
    const size_t tstep = (size_t)BM * K * 2;
    const size_t kstepA = g.a_tiled ? kstep : (size_t)(BK * 2), hstepA = g.a_tiled ? hstep : (size_t)HALF * g.lda * 2;
    const size_t tstepA = g.a_tiled ? tstep : 2 * hstepA;
    const unsigned ldsw = (unsigned)wid * 1024u;
    const int aoff = lds_byte(wr * 64 + fr, fq * 8), boff = lds_byte(wc * 32 + fr, fq * 8);
#define PG8_SA(b, h) (((b) * 2 + (h)) * HTB)
#define PG8_SB(b, h) ((4 + (b) * 2 + (h)) * HTB)
#define PG8_STAGE(bufoff, gbase, voff) do { _Pragma("unroll") for (int _i = 0; _i < 2; ++_i) \
        __builtin_amdgcn_global_load_lds((const unsigned*)((const char*)(gbase) + (voff)[_i]), (LAS unsigned*)(lds + (bufoff) + ldsw + _i * 8192), 16, 0, 0); } while (0)
#define PG8_LDA(dst, b, h) do { _Pragma("unroll") for (int m = 0; m < 4; ++m) _Pragma("unroll") for (int k = 0; k < 2; ++k) dst[m][k] = *(const LAS bf16x8*)(lds + PG8_SA(b, h) + aoff + m * 2048 + k * 1024); } while (0)
#define PG8_LDB(dst, b, h) do { _Pragma("unroll") for (int n = 0; n < 2; ++n) _Pragma("unroll") for (int k = 0; k < 2; ++k) dst[n][k] = *(const LAS bf16x8*)(lds + PG8_SB(b, h) + boff + n * 2048 + k * 1024); } while (0)
#define PG8_MMA(ai, bj, At, Bt) do { __builtin_amdgcn_s_setprio(1); _Pragma("unroll") for (int m = 0; m < 4; ++m) _Pragma("unroll") for (int n = 0; n < 2; ++n) _Pragma("unroll") for (int k = 0; k < 2; ++k) \
        acc[ai][bj][m][n] = __builtin_amdgcn_mfma_f32_16x16x32_bf16(Bt[n][k], At[m][k], acc[ai][bj][m][n], 0, 0, 0); __builtin_amdgcn_s_setprio(0); } while (0)
#define PG8_WAIT_V(n) asm volatile("s_waitcnt vmcnt(" #n ")" ::: "memory")
#define PG8_WAIT_L(n) asm volatile("s_waitcnt lgkmcnt(" #n ")" ::: "memory")
#define PG8_BAR __builtin_amdgcn_s_barrier()
#define PG8_SCHED __builtin_amdgcn_sched_barrier(0)
#ifndef DBG_GEMM_MODE
#define DBG_GEMM_MODE 0
#endif
    unsigned long long dbg_acc = 0, dbg_t0 = 0; (void)dbg_t0;
    Unit cur, nxt; int ui = 0;
    if (!S.next(0, cur)) return;
    Acc acc;
#pragma unroll
    for (int a = 0; a < 2; ++a)
#pragma unroll
        for (int b = 0; b < 2; ++b)
#pragma unroll
            for (int m = 0; m < 4; ++m)
#pragma unroll
                for (int n = 0; n < 2; ++n) acc[a][b][m][n] = (f32x4){0.f, 0.f, 0.f, 0.f};
    bf16x8 At[4][2], B0[2][2], B1[2][2];
    const char* cA = uni_ptr((const char*)g.A + (size_t)cur.pm * tstepA); const char* cB = uni_ptr((const char*)g.Bt + (size_t)cur.pn * tstep);
    PG8_STAGE(PG8_SB(0, 0), cB, voffB); PG8_STAGE(PG8_SB(0, 1), cB + hstep, voffB); PG8_STAGE(PG8_SA(0, 0), cA, voffA); PG8_STAGE(PG8_SA(0, 1), cA + hstepA, voffA);
    if (wr == 1) PG8_BAR;
    PG8_WAIT_V(2); PG8_BAR;
    PG8_STAGE(PG8_SB(1, 0), cB + kstep, voffB); PG8_STAGE(PG8_SA(1, 0), cA + kstepA, voffA); PG8_STAGE(PG8_SB(1, 1), cB + hstep + kstep, voffB);
    PG8_WAIT_V(6); PG8_BAR;
    for (;;) {
        const bool has_next = S.next(ui + 1, nxt);
        const char* nA = uni_ptr(has_next ? (const char*)g.A + (size_t)nxt.pm * tstepA : cA); const char* nB = uni_ptr(has_next ? (const char*)g.Bt + (size_t)nxt.pn * tstep : cB);
        if (DBG_GEMM_MODE == 3 && DBGP) dbg_t0 = __builtin_amdgcn_s_memrealtime();
        if (DBG_GEMM_MODE == 5 && DBGP && ui > 0) dbg_acc += __builtin_amdgcn_s_memrealtime() - dbg_t0;
        for (int t = 0; t < nt; t += 2) {
            if (DBG_GEMM_MODE == 2 && DBGP && t == 2) dbg_t0 = __builtin_amdgcn_s_memrealtime();
            if (DBG_GEMM_MODE == 3 && DBGP && t == 2) dbg_acc += __builtin_amdgcn_s_memrealtime() - dbg_t0;
            const bool last = (t == nt - 2);
            const char* a1 = cA + (size_t)(t + 1) * kstepA;
            const char* a2 = last ? nA : cA + (size_t)(t + 2) * kstepA; const char* b2 = last ? nB : cB + (size_t)(t + 2) * kstep;
            const char* a3 = a2 + kstepA; const char* b3 = b2 + kstep;
            PG8_LDB(B0, 0, 0); PG8_LDB(B1, 0, 1); PG8_SCHED; PG8_LDA(At, 0, 0); PG8_STAGE(PG8_SA(1, 1), a1 + hstepA, voffA);
            PG8_WAIT_V(8); PG8_WAIT_L(0); PG8_BAR; PG8_MMA(0, 0, At, B0); PG8_MMA(0, 1, At, B1); PG8_BAR; PG8_SCHED;
            PG8_LDA(At, 0, 1); PG8_STAGE(PG8_SB(0, 0), b2, voffB); PG8_STAGE(PG8_SB(0, 1), b2 + hstep, voffB); PG8_STAGE(PG8_SA(0, 0), a2, voffA);
            PG8_WAIT_V(8); PG8_WAIT_L(0); PG8_BAR; PG8_MMA(1, 0, At, B0); PG8_MMA(1, 1, At, B1); PG8_BAR; PG8_SCHED;
            PG8_LDB(B0, 1, 0); PG8_LDB(B1, 1, 1); PG8_SCHED; PG8_LDA(At, 1, 0); PG8_STAGE(PG8_SA(0, 1), a2 + hstepA, voffA);
            PG8_WAIT_V(8); PG8_WAIT_L(0); PG8_BAR; PG8_MMA(0, 0, At, B0); PG8_MMA(0, 1, At, B1); PG8_BAR; PG8_SCHED;
            PG8_LDA(At, 1, 1); PG8_STAGE(PG8_SB(1, 0), b3, voffB); PG8_STAGE(PG8_SB(1, 1), b3 + hstep, voffB); PG8_STAGE(PG8_SA(1, 0), a3, voffA);
            PG8_WAIT_V(8); PG8_WAIT_L(0); PG8_BAR; PG8_MMA(1, 0, At, B0); PG8_MMA(1, 1, At, B1); PG8_BAR; PG8_SCHED;
            if constexpr (Epi::MID_T >= 0) { if (t == Epi::MID_T) { E.mid(acc, cur, wr, wc, fr, fq); PG8_SCHED; } }
        }
        if (DBG_GEMM_MODE == 2 && DBGP) dbg_acc += __builtin_amdgcn_s_memrealtime() - dbg_t0;
        if (DBG_GEMM_MODE == 5 && DBGP) dbg_t0 = __builtin_amdgcn_s_memrealtime();
        if (wr == 0) PG8_BAR;
        if (DBG_GEMM_MODE == 1 && DBGP) dbg_t0 = __builtin_amdgcn_s_memrealtime();
        E(acc, cur, wr, wc, fr, fq);
#ifdef DBG_EPI2
        if (DBGP) { asm volatile("" ::: "memory"); E(acc, cur, wr, wc, fr, fq); }
#endif
        if (DBG_GEMM_MODE == 1 && DBGP) dbg_acc += __builtin_amdgcn_s_memrealtime() - dbg_t0;
        if (!has_next) break;
#pragma unroll
        for (int a = 0; a < 2; ++a)
#pragma unroll
            for (int b = 0; b < 2; ++b)
#pragma unroll
                for (int m = 0; m < 4; ++m)
#pragma unroll
                    for (int n = 0; n < 2; ++n) acc[a][b][m][n] = (f32x4){0.f, 0.f, 0.f, 0.f};
        cur = nxt; cA = nA; cB = nB; ++ui;
        if (wr == 1) PG8_BAR;
    }
    PG8_WAIT_V(0);
    PG8_BAR;
    if (DBG_GEMM_MODE && DBGP && blockIdx.x == 0 && tid == 0) *g.dbg = dbg_acc;
#undef PG8_SA
#undef PG8_SB
#undef PG8_STAGE
#undef PG8_LDA
#undef PG8_LDB
#undef PG8_MMA
#undef PG8_WAIT_V
#undef PG8_WAIT_L
#undef PG8_BAR
#undef PG8_SCHED
}
}

#define XB_TMO      128
#define XB_XCNT(j)  (256  + 64 * (j))
#define XB_XSUB(j)  (1280 + 64 * (j))
#define XB_XGEN(j)  (2304 + 64 * (j))
#define XB_TOP      3328
#define XB_TOPGEN   3392
#define XCD_BAR_WORDS 3456
#define XB_SPIN_CAP (1u << 18)

__device__ __forceinline__ unsigned xb_ld(unsigned* p)              { return __hip_atomic_load(p, __ATOMIC_RELAXED, __HIP_MEMORY_SCOPE_AGENT); }
__device__ __forceinline__ unsigned xb_add(unsigned* p, unsigned v) { return __hip_atomic_fetch_add(p, v, __ATOMIC_RELAXED, __HIP_MEMORY_SCOPE_AGENT); }
__device__ __forceinline__ unsigned xb_xcc_id() { return (unsigned)__builtin_amdgcn_s_getreg((3 << 11) | 20) & 0xFu; }
#define XB_SPIN(cond, bar) do { unsigned _sp = 0; while (cond) { __builtin_amdgcn_s_sleep(1); \
    if ((++_sp & 255u) == 0u) { if (xb_ld(&(bar)[XB_TMO])) break; if (_sp > XB_SPIN_CAP) { atomicAdd(&(bar)[XB_TMO], 1u); break; } } } } while (0)

struct XcdBarrier {
    unsigned* bar; unsigned x;
    volatile LAS unsigned* st;
};

__device__ __forceinline__ XcdBarrier xcd_barrier_post(unsigned* bar, volatile LAS unsigned* st) {
    XcdBarrier b; b.bar = bar; b.x = xb_xcc_id(); b.st = st;
    if (threadIdx.x == 0) (void)xb_add(&bar[XB_XCNT(b.x)], 1u);
    return b;
}
__device__ __forceinline__ void xcd_barrier_complete(unsigned* bar, unsigned x, unsigned& nloc, unsigned& nx) {
    const unsigned G = gridDim.x * gridDim.y * gridDim.z;
    unsigned sum, cnt, mine, sp = 0u;
    for (;;) {
        sum = 0u; cnt = 0u; mine = 0u;
#pragma unroll
        for (unsigned j = 0; j < 16; ++j) { const unsigned c = xb_ld(&bar[XB_XCNT(j)]); sum += c; cnt += (c > 0u) ? 1u : 0u; mine = (j == x) ? c : mine; }
        if (sum == G) break;
        __builtin_amdgcn_s_sleep(1);
        if ((++sp & 255u) == 0u) { if (xb_ld(&bar[XB_TMO])) break; if (sp > XB_SPIN_CAP) { atomicAdd(&bar[XB_TMO], 1u); break; } }
    }
    nloc = mine > 0u ? mine : 1u; nx = cnt > 0u ? cnt : 1u;
}

__device__ __forceinline__ void xcd_barrier(const XcdBarrier& b) {
    asm volatile("s_waitcnt vmcnt(0)" ::: "memory");
    __syncthreads();
    if (threadIdx.x == 0) {
        unsigned* bar = b.bar;
        __builtin_amdgcn_s_waitcnt(0);
        unsigned nloc = b.st[0], nx = b.st[1];
        if (nloc == 0u) { xcd_barrier_complete(bar, b.x, nloc, nx); b.st[0] = nloc; b.st[1] = nx; }
        const unsigned old = xb_add(&bar[XB_XSUB(b.x)], 1u);
        const unsigned gen = old / nloc;
        if (old + 1u == (gen + 1u) * nloc) {
            __builtin_amdgcn_fence(__ATOMIC_RELEASE, "agent");
            asm volatile("s_waitcnt vmcnt(0)" ::: "memory");
            const unsigned og = xb_add(&bar[XB_TOP], 1u);
            const unsigned tg = og / nx;
            if (og + 1u == (tg + 1u) * nx) xb_add(&bar[XB_TOPGEN], 1u);
            else XB_SPIN(xb_ld(&bar[XB_TOPGEN]) == tg, bar);
            __builtin_amdgcn_fence(__ATOMIC_ACQUIRE, "agent");
            xb_add(&bar[XB_XGEN(b.x)], 1u);
            asm volatile("s_waitcnt vmcnt(0)" ::: "memory");
        } else {
            XB_SPIN(xb_ld(&bar[XB_XGEN(b.x)]) == gen, bar);
            __builtin_amdgcn_fence(__ATOMIC_ACQUIRE, "agent");
            asm volatile("s_waitcnt vmcnt(0)" ::: "memory");
        }
    }
    __syncthreads();
}


__device__ __forceinline__ int otid() { int t = threadIdx.x; asm volatile("" : "+v"(t)); return t; }
__device__ __forceinline__ float wave_sum(float v) {
#pragma unroll
    for (int o = 1; o < 64; o <<= 1) v += __shfl_xor(v, o);
    return v;
}
__device__ __forceinline__ void transpose_item(const float* W, int N, const float* gain, bf16_t* WT, int ldk, int koff, int drow0, int k0, int n0, LAS float* scr, int lane) {
    const f32x4* src = (const f32x4*)(W + (size_t)(k0 + lane) * N + n0);
    f32x4 v[8];
#pragma unroll
    for (int j = 0; j < 8; ++j) v[j] = src[j];
    const float gsc = gain ? gain[k0 + lane] : 1.0f;
#pragma unroll
    for (int j = 0; j < 8; ++j) { scr[lane * 33 + 4 * j + 0] = v[j].x * gsc; scr[lane * 33 + 4 * j + 1] = v[j].y * gsc; scr[lane * 33 + 4 * j + 2] = v[j].z * gsc; scr[lane * 33 + 4 * j + 3] = v[j].w * gsc; }
    asm volatile("s_waitcnt lgkmcnt(0)" ::: "memory");
    const int c = lane & 7;
#pragma unroll
    for (int j = 0; j < 4; ++j) { const int n = (lane >> 3) + 8 * j; const LAS float* sp = scr + (8 * c) * 33 + n;
        u32x4 o; o.x = pk2(sp[0 * 33], sp[1 * 33]); o.y = pk2(sp[2 * 33], sp[3 * 33]); o.z = pk2(sp[4 * 33], sp[5 * 33]); o.w = pk2(sp[6 * 33], sp[7 * 33]);
        *(u32x4*)(WT + tiled_off(wslot(drow0 + n), koff + k0 + 8 * c, ldk >> 6)) = o; }
    asm volatile("s_waitcnt lgkmcnt(0)" ::: "memory");
}

struct Params {
    const float* in[18];
    float* out;
    unsigned char* ws;
};

__device__ __forceinline__ void norm_rows_bf16(const float* src, bf16_t* dst, float* rsout, int gw, int ngw, int lane) {
    for (int m = 2 * gw; m < MTOK; m += 2 * ngw) {
        const f32x4* xr = (const f32x4*)(src + (size_t)m * DM) + lane;
        f32x4 v[2][4]; float s0 = 0.f, s1 = 0.f;
#pragma unroll
        for (int j = 0; j < 4; ++j) { v[0][j] = xr[64 * j]; v[1][j] = xr[256 + 64 * j]; }
#pragma unroll
        for (int j = 0; j < 4; ++j) { s0 += (v[0][j].x * v[0][j].x + v[0][j].y * v[0][j].y) + (v[0][j].z * v[0][j].z + v[0][j].w * v[0][j].w);
                                      s1 += (v[1][j].x * v[1][j].x + v[1][j].y * v[1][j].y) + (v[1][j].z * v[1][j].z + v[1][j].w * v[1][j].w); }
        const float r0 = 1.0f / sqrtf(wave_sum(s0) * (1.0f / DM) + EPS), r1 = 1.0f / sqrtf(wave_sum(s1) * (1.0f / DM) + EPS);
        if (lane == 0) { rsout[m] = r0; rsout[m + 1] = r1; }
#pragma unroll
        for (int j = 0; j < 4; ++j) { u32x2 w; w.x = pk2(v[0][j].x * r0, v[0][j].y * r0); w.y = pk2(v[0][j].z * r0, v[0][j].w * r0); *(u32x2*)(dst + tiled_off(m, 4 * lane + 256 * j, DM / 64)) = w;
                                      u32x2 w1; w1.x = pk2(v[1][j].x * r1, v[1][j].y * r1); w1.y = pk2(v[1][j].z * r1, v[1][j].w * r1); *(u32x2*)(dst + tiled_off(m + 1, 4 * lane + 256 * j, DM / 64)) = w1; }
    }
}
__device__ __forceinline__ void rowscale_phase(const float* ssq, float* rs, int gtid, int nth) {
    for (int row = gtid; row < MTOK; row += nth) {
        const f32x4* pp = (const f32x4*)(ssq + (size_t)row * 16);
        const f32x4 a = pp[0], b = pp[1], c = pp[2], d = pp[3];
        const float sum = ((a.x + a.y) + (a.z + a.w)) + ((b.x + b.y) + (b.z + b.w)) + ((c.x + c.y) + (c.z + c.w)) + ((d.x + d.y) + (d.z + d.w));
        rs[row] = 1.0f / sqrtf(sum * (1.0f / DM) + EPS);
    }
}

__device__ __forceinline__ void attn_load_block(LAS unsigned char* lds, const bf16_t* kp0, const bf16_t* vp0, int kvld, int tokbase, int d, int blk, int tid) {
    const int ch = tid & 7, rw = tid >> 3;
    u32x4 tmp[8];
#pragma unroll
    for (int i = 0; i < 8; ++i) { const int mat = i >> 1, row = rw + 64 * (i & 1); const int tok = tokbase + d * (blk * 128 + row);
        tmp[i] = *(const u32x4*)(((mat < 2) ? kp0 : vp0) + (size_t)tok * kvld + (mat & 1) * 64 + ch * 8); }
#pragma unroll
    for (int i = 0; i < 8; ++i) { const int mat = i >> 1, row = (blk & 1) * 128 + rw + 64 * (i & 1); *(LAS u32x4*)(lds + mat * 36864 + row * 144 + ch * 16) = tmp[i]; }
}
#define ATT_BAR() do { asm volatile("s_waitcnt lgkmcnt(0)" ::: "memory"); __builtin_amdgcn_s_barrier(); asm volatile("" ::: "memory"); } while (0)
__device__ __forceinline__ void attn_phase(LAS unsigned char* lds, bf16_t* Z, bf16_t* YAB, float* LSE, const float* lutg, const float* sinks, int G, int wg) {
    int tid_o = threadIdx.x; asm volatile("" : "+v"(tid_o));
    const int tid = tid_o, wv = __builtin_amdgcn_readfirstlane(tid >> 6), lane = tid & 63, r = lane & 31, h = lane >> 5;
    LAS float* lutl = (LAS float*)(lds + 147456);
    for (int sid = wg; sid < 1792; sid += G) {
        int isB, gi, d, hp, bt, rs, b0, len;
        if (sid < 256) { isB = 0; gi = 0; d = 1; const int chain = sid >> 2; hp = chain & 1; bt = chain >> 1; rs = 0; b0 = (sid & 3) * 4; len = 4; }
        else if (sid < 512) { const int c = sid - 256; isB = 0; gi = 1; d = 4; hp = c & 1; const int seq = c >> 1; bt = seq >> 2; rs = seq & 3; b0 = 0; len = 4; }
        else if (sid < 1536) { const int c = sid - 512; isB = 0; gi = 2; d = 16; hp = c & 1; const int seq = c >> 1; bt = seq >> 4; rs = seq & 15; b0 = 0; len = 1; }
        else { const int c = sid - 1536; isB = 1; gi = 0; d = 1; hp = 0; bt = c >> 3; rs = 0; b0 = (c & 7) * 2; len = 2; }
        const int tokbase = bt * SEQ + rs;
        const bf16_t* kp0 = isB ? (Z + ZO_KVB) : (Z + ZO_KA + (4 * gi + 2 * hp) * 64); const bf16_t* vp0 = isB ? (Z + ZO_KVB + 128) : (Z + ZO_VA + (4 * gi + 2 * hp) * 64);
        const int kvld = isB ? 256 : 768, qld = isB ? 512 : 768;
        for (int b = b0; b < b0 + len; ++b) {
        ATT_BAR();
        if (b == b0) {
            if (b0 > 0) attn_load_block(lds, kp0, vp0, kvld, tokbase, d, b0 - 1, tid);
            const int nh = isB ? 8 : 2, headbase = isB ? 12 : 4 * gi + 2 * hp;
            for (int idx = tid; idx < nh * LUTP; idx += 512) lutl[idx] = lutg[headbase * LUTP + idx];
        }
        attn_load_block(lds, kp0, vp0, kvld, tokbase, d, b, tid);
        ATT_BAR();
        const int nrounds = isB ? 4 : 1;
        for (int rd = 0; rd < nrounds; ++rd) {
            int slot, rt, qcol, lh, qh = 0; float sink = NEGBIG;
            if (!isB) { slot = wv >> 2; rt = wv & 3; qcol = (4 * gi + 2 * hp + slot) * 64; lh = slot; }
            else { const int tk = rd * 8 + wv; qh = tk >> 2; rt = tk & 3; slot = qh >> 2; qcol = qh * 64; lh = qh; sink = sinks[qh] * LOG2E; }
            bf16_t* qbase = Z + (isB ? ZO_QB : ZO_QA) + qcol;
            const int qi = 32 * rt + r;
            const size_t qtok = (size_t)(tokbase + d * (b * 128 + qi));
            const bf16_t* qp = qbase + qtok * qld + 8 * h;
            bf16x8 qf[4];
#pragma unroll
            for (int s = 0; s < 4; ++s) qf[s] = *(const bf16x8*)(qp + 16 * s);
            const LAS unsigned char* Ks = lds + slot * 36864;
            const LAS unsigned char* Vs = lds + 73728 + slot * 36864;
            const int dk_start = (b == 0) ? ((4 - rt) > 0 ? (4 - rt) : 0) : 0;
            f32x16 X[5];
            if (dk_start == 0) {
#pragma unroll
                for (int dk = 0; dk < 5; ++dk) {
                    const LAS float* lp = lutl + lh * LUTP + 32 + 128 - 32 * dk + r - 4 * h;
#pragma unroll
                    for (int i = 0; i < 16; ++i) X[dk][i] = lp[-((i & 3) + 8 * (i >> 2))];
                }
#pragma unroll
                for (int s = 0; s < 4; ++s) {
                    bf16x8 kf[5];
#pragma unroll
                    for (int dk = 0; dk < 5; ++dk) { const int kt = rt + dk; const int lrow = (((b - 1 + (kt >> 2)) & 1) << 7) + ((kt & 3) << 5);
                        kf[dk] = *(const LAS bf16x8*)(Ks + (lrow + r) * 144 + 16 * h + 32 * s); }
#pragma unroll
                    for (int dk = 0; dk < 5; ++dk) X[dk] = __builtin_amdgcn_mfma_f32_32x32x16_bf16(kf[dk], qf[s], X[dk], 0, 0, 0);
                }
            } else {
#pragma unroll
            for (int dk = 0; dk < 5; ++dk) {
                if (dk >= dk_start) {
                    const int kt = rt + dk;
                    const int lrow = (((b - 1 + (kt >> 2)) & 1) << 7) + ((kt & 3) << 5);
                    const LAS unsigned char* kp = Ks + (lrow + r) * 144 + 16 * h;
                    const LAS float* lp = lutl + lh * LUTP + 32 + 128 - 32 * dk + r - 4 * h;
                    f32x16 x;
#pragma unroll
                    for (int i = 0; i < 16; ++i) x[i] = lp[-((i & 3) + 8 * (i >> 2))];
                    bf16x8 kf[4];
#pragma unroll
                    for (int s = 0; s < 4; ++s) kf[s] = *(const LAS bf16x8*)(kp + 32 * s);
#pragma unroll
                    for (int s = 0; s < 4; ++s) x = __builtin_amdgcn_mfma_f32_32x32x16_bf16(kf[s], qf[s], x, 0, 0, 0);
                    X[dk] = x;
                } else {
#pragma unroll
                    for (int i = 0; i < 16; ++i) X[dk][i] = NEGBIG;
                }
            }
            }
            float mxp[4] = {NEGBIG, NEGBIG, NEGBIG, NEGBIG};
#pragma unroll
            for (int dk = 0; dk < 5; ++dk)
#pragma unroll
                for (int i = 0; i < 16; ++i) mxp[i & 3] = fmaxf(mxp[i & 3], X[dk][i]);
            float mx = fmaxf(fmaxf(mxp[0], mxp[1]), fmaxf(mxp[2], mxp[3]));
            mx = fmaxf(mx, __shfl_xor(mx, 32));
            mx = fmaxf(mx, sink);
            float lp4[4] = {0.f, 0.f, 0.f, 0.f};
#pragma unroll
            for (int dk = 0; dk < 5; ++dk)
#pragma unroll
                for (int i = 0; i < 16; ++i) { const float p = __builtin_amdgcn_exp2f(X[dk][i] - mx); X[dk][i] = p; lp4[i & 3] += p; }
            float l = (lp4[0] + lp4[1]) + (lp4[2] + lp4[3]);
            l += __shfl_xor(l, 32);
            if (isB) l += __builtin_amdgcn_exp2f(sink - mx);
            f32x16 O[2];
#pragma unroll
            for (int i = 0; i < 16; ++i) { O[0][i] = 0.f; O[1][i] = 0.f; }
            const int i16 = lane & 15, tq = i16 >> 2, tp = i16 & 3;
            const LAS unsigned char* vbase = Vs + (4 * h + tq) * 144 + 32 * ((lane >> 4) & 1) + 8 * tp;
#pragma unroll
            for (int dk = 0; dk < 5; ++dk) {
                if (dk >= dk_start) {
                    const int kt = rt + dk;
                    const int lrow = (((b - 1 + (kt >> 2)) & 1) << 7) + ((kt & 3) << 5);
#pragma unroll
                    for (int s = 0; s < 2; ++s) {
                        u32x4 pw; pw.x = pk2(X[dk][8 * s + 0], X[dk][8 * s + 1]); pw.y = pk2(X[dk][8 * s + 2], X[dk][8 * s + 3]); pw.z = pk2(X[dk][8 * s + 4], X[dk][8 * s + 5]); pw.w = pk2(X[dk][8 * s + 6], X[dk][8 * s + 7]);
                        const bf16x8 pf = __builtin_bit_cast(bf16x8, pw);
#pragma unroll
                        for (int dt = 0; dt < 2; ++dt) {
                            const LAS unsigned char* va = vbase + (lrow + 16 * s) * 144 + 64 * dt;
                            const s16x4 lo = __builtin_amdgcn_ds_read_tr16_b64_v4i16((LAS s16x4*)(va));
                            const s16x4 hi = __builtin_amdgcn_ds_read_tr16_b64_v4i16((LAS s16x4*)(va + 8 * 144));
                            const bf16x8 vf = __builtin_shufflevector(lo, hi, 0, 1, 2, 3, 4, 5, 6, 7);
                            O[dt] = __builtin_amdgcn_mfma_f32_32x32x16_bf16(vf, pf, O[dt], 0, 0, 0);
                        }
                    }
                }
            }
            const float inv = 1.0f / l;
            bf16_t* op = qbase + qtok * qld;
#pragma unroll
            for (int dt = 0; dt < 2; ++dt)
#pragma unroll
                for (int pr = 0; pr < 2; ++pr) {
                    const int ga = 2 * pr, gb = 2 * pr + 1;
                    const unsigned x0 = pk2(O[dt][4 * ga] * inv, O[dt][4 * ga + 1] * inv), x1 = pk2(O[dt][4 * ga + 2] * inv, O[dt][4 * ga + 3] * inv);
                    const unsigned y0 = pk2(O[dt][4 * gb] * inv, O[dt][4 * gb + 1] * inv), y1 = pk2(O[dt][4 * gb + 2] * inv, O[dt][4 * gb + 3] * inv);
                    const u32x2 s0 = __builtin_amdgcn_permlane32_swap(x0, y0, false, false), s1 = __builtin_amdgcn_permlane32_swap(x1, y1, false, false);
                    u32x4 w; w.x = s0.x; w.y = s1.x; w.z = s0.y; w.w = s1.y;
                    if (isB) *(u32x4*)(YAB + tiled_off((int)qtok, 256 + qcol + 32 * dt + 8 * (2 * pr + h), 12)) = w;
                    else *(u32x4*)(op + 32 * dt + 8 * (2 * pr + h)) = w;
                }
            if (!isB && h == 0) LSE[((size_t)gi * MTOK + qtok) * 4 + 2 * hp + slot] = mx + __builtin_amdgcn_logf(l);
        }
        }
    }
}

__device__ __forceinline__ void combine_phase(const bf16_t* Z, const float* LSE, bf16_t* YAB, int gtid, int nth) {
    for (int idx = gtid; idx < MTOK * 32; idx += nth) {
        const int tok = idx >> 5; const int c = (int)(idx & 31), s = c >> 3, e0 = (c & 7) * 8;
        const float l0 = LSE[((size_t)0 * MTOK + tok) * 4 + s], l1 = LSE[((size_t)1 * MTOK + tok) * 4 + s], l2 = LSE[((size_t)2 * MTOK + tok) * 4 + s];
        const float mx = fmaxf(l0, fmaxf(l1, l2));
        const float w0 = __builtin_amdgcn_exp2f(l0 - mx), w1 = __builtin_amdgcn_exp2f(l1 - mx), w2 = __builtin_amdgcn_exp2f(l2 - mx);
        const float inv = 1.0f / (w0 + w1 + w2);
        const float a0 = w0 * inv, a1 = w1 * inv, a2 = w2 * inv;
        const bf16_t* zr = Z + ZO_QA + (size_t)tok * 768 + s * 64 + e0;
        const u32x4 o0 = *(const u32x4*)(zr), o1 = *(const u32x4*)(zr + 256), o2 = *(const u32x4*)(zr + 512);
        u32x4 w;
#pragma unroll
        for (int q = 0; q < 4; ++q) {
            const float lo = a0 * bf_lo(o0[q]) + a1 * bf_lo(o1[q]) + a2 * bf_lo(o2[q]);
            const float hi = a0 * bf_hi(o0[q]) + a1 * bf_hi(o1[q]) + a2 * bf_hi(o2[q]);
            w[q] = pk2(lo, hi);
        }
        *(u32x4*)(YAB + tiled_off(tok, s * 64 + e0, 12)) = w;
    }
}

#ifndef DBG_A
#define DBG_A -1
#endif
#ifndef DBG_B
#define DBG_B -1
#endif
#ifndef DBG_DOUBLE
#define DBG_DOUBLE -1
#endif
#ifndef DBG_GEMM_PHASE
#define DBG_GEMM_PHASE -1
#endif
#define GDBG(k) ((DBG_GEMM_PHASE == (k)) ? (unsigned long long*)(p.ws + MiB) + 20 : (unsigned long long*)nullptr)
#define REP(k) for (int rep_ = 0; rep_ < ((DBG_DOUBLE == (k)) ? 2 : 1); ++rep_)
#define TSTAMP(k) do { if (DBG_A >= 0 && wg == 0 && threadIdx.x == 0) { ((unsigned long long*)(p.ws + MiB))[k] = __builtin_amdgcn_s_memrealtime(); ((unsigned long long*)(p.ws + MiB))[32 + k] = __builtin_amdgcn_s_memtime(); } } while (0)
#ifndef PHASE_MASK
#define PHASE_MASK 0xFFFFu
#endif
#define PH(k) ((PHASE_MASK >> (k)) & 1u)

__global__ void __launch_bounds__(512, 2) fwd_kernel(Params p) {
    extern __shared__ __attribute__((aligned(16))) unsigned char lds_raw[];
    LAS unsigned char* lds = (LAS unsigned char*)lds_raw;
    cg::grid_group grid = cg::this_grid();
    const int G = gridDim.x, wg = blockIdx.x, ngw = G * 8;
    if (threadIdx.x < 16) ((LAS unsigned*)(lds + LDS_CTL_OFF))[threadIdx.x] = 0u;
    __syncthreads();
    const XcdBarrier xbar = xcd_barrier_post((unsigned*)p.ws, (volatile LAS unsigned*)(lds + LDS_CTL_OFF));
#define PHASE_IDS const int tid = otid(), lane = tid & 63, wave = __builtin_amdgcn_readfirstlane(tid >> 6), gw = wg * 8 + wave; (void)lane; (void)gw;
#define Wgu1 ((bf16_t*)(p.ws + WS_WGU1))
#define Wd1 ((bf16_t*)(p.ws + WS_WD1))
#define Win ((bf16_t*)(p.ws + WS_WIN))
#define Wbr ((bf16_t*)(p.ws + WS_WBR))
#define Wout ((bf16_t*)(p.ws + WS_WOUT))
#define Wgu2 ((bf16_t*)(p.ws + WS_WGU2))
#define Wd2 ((bf16_t*)(p.ws + WS_WD2))
#define lutg ((float*)(p.ws + WS_LUT))
#define LSE ((float*)(p.ws + WS_LSE))
#define XN ((bf16_t*)(p.ws + WS_XN))
#define HB ((bf16_t*)(p.ws + WS_HB))
#define RS ((float*)(p.ws + WS_RS))
#define SSQ ((float*)(p.ws + WS_SSQ))
#define YAB ((bf16_t*)(p.ws + WS_XN))
#define Z ((bf16_t*)(p.ws + WS_Z))
#define HID ((bf16_t*)(p.ws + WS_Z))

    TSTAMP(0);
#ifdef DBG_XCC
    if (wg == 0 && threadIdx.x == 0) *((unsigned*)(p.ws + MiB + 4096)) = 0u;
#endif
    REP(0) if (PH(0)) {
        PHASE_IDS
        LAS float* scr = (LAS float*)(lds + wave * 16384);
        constexpr int I_GU = 16 * 88, I_DN = 44 * 32, I_IN = 16 * 160, I_BA = 4 * 32, I_BB = 8 * 32, I_OUT = 16 * 32;
        constexpr int NITEMS = 6 * I_GU + I_IN + I_BA + I_BB + I_OUT;
        for (int it = gw; it < NITEMS; it += ngw) {
            int rr = it;
            bool done = false;
#pragma unroll
            for (int f = 0; f < 4; ++f) {
                if (!done && rr < I_GU) { const int kb = rr / 88, nb = rr % 88, n0 = nb * 32; const int which = f & 1, layer = f >> 1;
                    const float* W = p.in[layer ? (which ? 15 : 14) : (which ? 3 : 2)]; const float* gain = p.in[layer ? 13 : 1];
                    transpose_item(W, DFF, gain, layer ? Wgu2 : Wgu1, DM, 0, (n0 / 128) * 256 + which * 128 + (n0 % 128), kb * 64, n0, scr, lane); done = true; }
                if (!done) rr -= I_GU;
            }
            if (done) continue;
            if (rr < I_DN) { transpose_item(p.in[4], DM, nullptr, Wd1, DFF, 0, (rr % 32) * 32, (rr / 32) * 64, (rr % 32) * 32, scr, lane); continue; } rr -= I_DN;
            if (rr < I_DN) { transpose_item(p.in[16], DM, nullptr, Wd2, DFF, 0, (rr % 32) * 32, (rr / 32) * 64, (rr % 32) * 32, scr, lane); continue; } rr -= I_DN;
            if (rr < I_IN) { transpose_item(p.in[6], DIN, p.in[5], Win, DM, 0, (rr % 160) * 32, (rr / 160) * 64, (rr % 160) * 32, scr, lane); continue; } rr -= I_IN;
            if (rr < I_BA) { transpose_item(p.in[8], DM, nullptr, Wbr, 768, 0, (rr % 32) * 32, (rr / 32) * 64, (rr % 32) * 32, scr, lane); continue; } rr -= I_BA;
            if (rr < I_BB) { transpose_item(p.in[9], DM, nullptr, Wbr, 768, 256, (rr % 32) * 32, (rr / 32) * 64, (rr % 32) * 32, scr, lane); continue; } rr -= I_BB;
            transpose_item(p.in[10], DM, nullptr, Wout, DM, 0, (rr % 32) * 32, (rr / 32) * 64, (rr % 32) * 32, scr, lane);
        }
        if (wg == 0) {
            const float* rel = p.in[12];
            for (int idx = tid; idx < 20 * LUTP; idx += 512) {
                const int hd = idx / LUTP, dist = idx % LUTP - 32;
                const int dil = (hd < 4) ? 1 : ((hd < 8) ? 4 : ((hd < 12) ? 16 : 1));
                const int maxs = (hd < 12) ? 128 : 127;
                float v = NEGBIG;
                if (dist >= 0 && dist <= maxs) {
                    const int n = dist * dil; int bucket;
                    if (n < 16) bucket = n;
                    else { const float nf = (float)n; int lg = 16 + (int)(logf(nf / 16.0f) / 4.852030263919617f * 16.0f); bucket = lg < 31 ? lg : 31; }
                    v = rel[bucket * 20 + hd] * LOG2E;
                }
                lutg[idx] = v;
            }
        }
        norm_rows_bf16(p.in[0], XN, RS, gw, ngw, lane);
    }
    if (G > (1 << 24)) grid.sync();
    xcd_barrier(xbar); TSTAMP(1);
#ifdef DBG_XCC
    if (threadIdx.x == 0) { const unsigned xcc = (unsigned)__builtin_amdgcn_s_getreg((3 << 11) | 20) & 0xFu; if (xcc != (unsigned)(wg & 7)) atomicAdd((unsigned*)(p.ws + MiB + 4096), 1u); }
#endif
    REP(1) if (PH(1)) { pg8::Gemm g{XN, Wgu1, MTOK, 2 * DFF, DM, DM, 1, GDBG(1)}; pg8::StaticOrder S; S.init(MTOK, 2 * DFF, G, wg); pg8::EpiSwiGLU E{HID, nullptr}; pg8::gemm_phase<pg8::EpiSwiGLU, (DBG_GEMM_PHASE == 1)>(lds, g, S, E); }
    xcd_barrier(xbar); TSTAMP(2);
    REP(2) if (PH(2)) { pg8::Gemm g{HID, Wd1, MTOK, DM, DFF, DFF, 1, GDBG(2)}; pg8::StaticOrder S; S.init(MTOK, DM, G, wg); pg8::EpiHB E{XN, RS, HB, SSQ, 0.5f}; pg8::gemm_phase<pg8::EpiHB, (DBG_GEMM_PHASE == 2)>(lds, g, S, E); }
    xcd_barrier(xbar); TSTAMP(3);
    REP(3) if (PH(3)) rowscale_phase(SSQ, RS, wg * 512 + otid(), G * 512);
    xcd_barrier(xbar); TSTAMP(4);
    REP(4) if (PH(4)) { pg8::Gemm g{HB, Win, MTOK, DIN, DM, DM, 1, GDBG(4)}; pg8::StaticOrder S; S.init(MTOK, DIN, G, wg); pg8::EpiZ E{Z, p.in[7], RS}; pg8::gemm_phase<pg8::EpiZ, (DBG_GEMM_PHASE == 4)>(lds, g, S, E); }
    xcd_barrier(xbar); TSTAMP(5);
    REP(5) if (PH(5)) attn_phase(lds, Z, YAB, LSE, lutg, p.in[11], G, wg);
    xcd_barrier(xbar); TSTAMP(6);
    REP(6) if (PH(6)) combine_phase(Z, LSE, YAB, wg * 512 + otid(), G * 512);
    xcd_barrier(xbar); TSTAMP(7);
    REP(7) if (PH(7)) { pg8::Gemm g{YAB, Wbr, MTOK, DM, 768, 768, 1, GDBG(7)}; pg8::StaticOrder S; S.init(MTOK, DM, G, wg); pg8::EpiMerge E{Z + ZO_KA, Z}; pg8::gemm_phase<pg8::EpiMerge, (DBG_GEMM_PHASE == 7)>(lds, g, S, E); }
    xcd_barrier(xbar); TSTAMP(8);
    REP(8) if (PH(8)) { pg8::Gemm g{Z + ZO_KA, Wout, MTOK, DM, DM, DM, 1, GDBG(8)}; pg8::StaticOrder S; S.init(MTOK, DM, G, wg); pg8::EpiHB E{HB, nullptr, HB, SSQ, 1.0f}; pg8::gemm_phase<pg8::EpiHB, (DBG_GEMM_PHASE == 8)>(lds, g, S, E); }
    xcd_barrier(xbar); TSTAMP(9);
    REP(9) if (PH(9)) rowscale_phase(SSQ, RS, wg * 512 + otid(), G * 512);
    xcd_barrier(xbar); TSTAMP(10);
    REP(10) if (PH(10)) { pg8::Gemm g{HB, Wgu2, MTOK, 2 * DFF, DM, DM, 1, GDBG(10)}; pg8::StaticOrder S; S.init(MTOK, 2 * DFF, G, wg); pg8::EpiSwiGLU E{HID, RS}; pg8::gemm_phase<pg8::EpiSwiGLU, (DBG_GEMM_PHASE == 10)>(lds, g, S, E); }
    xcd_barrier(xbar); TSTAMP(11);
    REP(11) if (PH(11)) { pg8::Gemm g{HID, Wd2, MTOK, DM, DFF, DFF, 1, GDBG(11)}; pg8::StaticOrder S; S.init(MTOK, DM, G, wg); pg8::EpiHB E{HB, nullptr, HB, SSQ, 0.5f}; pg8::gemm_phase<pg8::EpiHB, (DBG_GEMM_PHASE == 11)>(lds, g, S, E); }
    xcd_barrier(xbar); TSTAMP(12);
    REP(12) if (PH(12)) {
        PHASE_IDS
        const float* gf = p.in[17];
        f32x4 gv[4];
#pragma unroll
        for (int j = 0; j < 4; ++j) gv[j] = *((const f32x4*)gf + lane + 64 * j);
        for (int m = 2 * gw; m < MTOK; m += 2 * ngw) {
            u32x2 hv[2][4]; float ps[2];
#pragma unroll
            for (int q = 0; q < 2; ++q) {
#pragma unroll
                for (int j = 0; j < 4; ++j) hv[q][j] = *(const u32x2*)(HB + tiled_off(m + q, 4 * lane + 256 * j, DM / 64));
                ps[q] = SSQ[(size_t)(m + q) * 16 + (lane & 15)];
            }
#pragma unroll
            for (int q = 0; q < 2; ++q) {
                float sum = ps[q];
#pragma unroll
                for (int o = 1; o < 16; o <<= 1) sum += __shfl_xor(sum, o);
                const float r = 1.0f / sqrtf(sum * (1.0f / DM) + EPS);
                f32x4* orow = (f32x4*)(p.out + (size_t)(m + q) * DM) + lane;
#pragma unroll
                for (int j = 0; j < 4; ++j) { const u32x2 a = hv[q][j]; orow[64 * j] = (f32x4){bf_lo(a.x), bf_hi(a.x), bf_lo(a.y), bf_hi(a.y)} * r * gv[j]; }
            }
        }
    }
    if (DBG_A >= 0) {
        grid.sync();
        if (wg == 0) { const unsigned long long* tsp = (const unsigned long long*)(p.ws + MiB);
#ifdef DBG_XCC
            const long n = 100 + 10 * (long)(*((const unsigned*)(p.ws + MiB + 4096)));
#else
#ifdef DBG_CLOCK
            const long n = (long)((tsp[32 + DBG_B] - tsp[32 + DBG_A]) * 100 / (tsp[DBG_B] - tsp[DBG_A]));
#else
            const long n = DBG_GEMM_MODE ? (long)(tsp[20] / 10) : (long)(tsp[DBG_B >= 0 ? DBG_B : 0] - tsp[DBG_A >= 0 ? DBG_A : 0]) / 10;
#endif
#endif

            for (long i = threadIdx.x; i < n; i += 512) p.out[(size_t)i * 997 + 3] += 0.1f; }
    }
}

#undef Z
#undef XN
#undef HB
#undef RS
#undef SSQ
#undef YAB
#undef HID
#undef LSE
#undef lutg
extern "C" void kernel_launch(void* const* d_in, const int* in_sizes, int n_in, void* d_out, int out_size, void* d_ws, size_t ws_size, hipStream_t stream) {
    static int grid = 0;
    if (grid == 0) {
        if (n_in != 18 || out_size != MTOK * DM || ws_size < WS_END) { fprintf(stderr, "kernel_launch: unexpected shapes (n_in %d out %d ws %zu)\n", n_in, out_size, ws_size); grid = -1; return; }
        int dev = 0, cus = 0, per_cu = 0;
        if (hipGetDevice(&dev) != hipSuccess || hipDeviceGetAttribute(&cus, hipDeviceAttributeMultiprocessorCount, dev) != hipSuccess) { grid = -1; return; }
        if (hipFuncSetAttribute((const void*)fwd_kernel, hipFuncAttributeMaxDynamicSharedMemorySize, LDS_BYTES) != hipSuccess) { fprintf(stderr, "hipFuncSetAttribute failed\n"); grid = -1; return; }
        if (hipOccupancyMaxActiveBlocksPerMultiprocessor(&per_cu, (const void*)fwd_kernel, 512, LDS_BYTES) != hipSuccess || per_cu < 1) per_cu = 1;
        (void)hipGetLastError();
        grid = cus * per_cu;
    }
    if (grid < 0) return;
    if (hipMemsetAsync(d_ws, 0, XCD_BAR_WORDS * 4, stream) != hipSuccess) { fprintf(stderr, "memset failed\n"); return; }
    Params p{};
    for (int i = 0; i < 18; ++i) p.in[i] = (const float*)d_in[i];
    p.out = (float*)d_out; p.ws = (unsigned char*)d_ws;
    void* args[] = {&p};
    hipError_t e = hipLaunchCooperativeKernel((const void*)fwd_kernel, dim3(grid), dim3(512), args, LDS_BYTES, stream);
    if (e != hipSuccess) fprintf(stderr, "cooperative launch failed: %s (grid %d)\n", hipGetErrorString(e), grid);
}
```

```cpp
#include <hip/hip_runtime.h>
#include <hip/hip_cooperative_groups.h>
#include <cstdio>
namespace cg = cooperative_groups;

#define LAS __attribute__((address_space(3)))
typedef unsigned short bf16_t;
typedef short bf16x8 __attribute__((ext_vector_type(8)));
typedef short s16x4 __attribute__((ext_vector_type(4)));
typedef float f32x4 __attribute__((ext_vector_type(4)));
typedef float f32x2 __attribute__((ext_vector_type(2)));
typedef float f32x16 __attribute__((ext_vector_type(16)));
typedef unsigned u32x4 __attribute__((ext_vector_type(4)));
typedef unsigned u32x2 __attribute__((ext_vector_type(2)));
typedef __bf16 bf16x2v __attribute__((ext_vector_type(2)));

constexpr int MTOK = 65536, DM = 1024, DFF = 2816, DIN = 5120, SEQ = 2048;
constexpr float EPS = 1e-6f, LOG2E = 1.4426950408889634f, QSCALE = 0.125f * 1.4426950408889634f, NEGBIG = -1e30f;
constexpr int ZAQ = 0, ZAK = 768, ZAV = 1536, ZBQ = 2304, ZBK = 2816, ZBV = 2944, ZGA = 3072, ZGB = 4096;
constexpr size_t ZO_KA = 0, ZO_VA = (size_t)MTOK * 768, ZO_QA = (size_t)MTOK * 1536, ZO_QB = (size_t)MTOK * 2304, ZO_KVB = (size_t)MTOK * 2816, ZO_G = (size_t)MTOK * 3072;
constexpr int LUTP = 192;
constexpr int LDS_CTL_OFF = 147456 + 8 * LUTP * 4;
constexpr int LDS_BYTES = LDS_CTL_OFF + 64;

constexpr size_t MiB = 1u << 20;
constexpr size_t WS_WGU1 = 2 * MiB, WS_WD1 = 14 * MiB, WS_WIN = 20 * MiB, WS_WBR = 30 * MiB, WS_WOUT = 32 * MiB, WS_WGU2 = 34 * MiB, WS_WD2 = 46 * MiB;
constexpr size_t WS_LUT = 52 * MiB, WS_LSE = 53 * MiB, WS_RS = 56 * MiB, WS_SSQ = 57 * MiB, WS_XN = 64 * MiB, WS_HB = 192 * MiB, WS_Z = 320 * MiB, WS_END = 960 * MiB;

__device__ __forceinline__ unsigned pk2(float lo, float hi) { f32x2 f = {lo, hi}; return __builtin_bit_cast(unsigned, __builtin_convertvector(f, bf16x2v)); }
__device__ __forceinline__ float bf_lo(unsigned u) { return __uint_as_float(u << 16); }
__device__ __forceinline__ float bf_hi(unsigned u) { return __uint_as_float(u & 0xffff0000u); }
__device__ __forceinline__ float fast_sigmoid(float v) { return __builtin_amdgcn_rcpf(1.0f + __builtin_amdgcn_exp2f(-v * LOG2E)); }

__device__ __forceinline__ size_t tiled_off(int row, int col, int ktiles) {
    const int r = row & 127, c = col & 63;
    const int st = (r >> 4) * 2 + (c >> 5), ob = (r & 15) * 64 + (c & 31) * 2;
    const int byte = st * 1024 + (ob ^ (((ob >> 9) & 1) << 5));
    return ((size_t)(((row >> 8) * ktiles + (col >> 6)) * 2 + ((row >> 7) & 1))) * 8192 + (byte >> 1);
}
__device__ __forceinline__ int wslot(int x) { return (x & ~31) | ((((x >> 2) & 1) << 4) | (((x >> 3) & 3) << 2) | (x & 3)); }
__device__ __forceinline__ const char* uni_ptr(const char* p) { const unsigned long long v = (unsigned long long)p; const unsigned lo = __builtin_amdgcn_readfirstlane((unsigned)v), hi = __builtin_amdgcn_readfirstlane((unsigned)(v >> 32)); return (const char*)(((unsigned long long)hi << 32) | lo); }
namespace pg8 {
constexpr int BM = 256, BK = 64, HALF = 128, HTB = HALF * BK * 2, STAGE_BYTES = 8 * HTB, NXCD = 8, WGM = 8;
__host__ __device__ __forceinline__ int lds_byte(int r, int c) { const int st = (r >> 4) * 2 + (c >> 5), rr = r & 15, cc = c & 31, ob = rr * 64 + cc * 2; return st * 1024 + (ob ^ (((ob >> 9) & 1) << 5)); }
__host__ __device__ __forceinline__ void stage_rc(int b, int& R, int& C) { const int st = b / 1024, sb = b % 1024, swz = sb ^ (((sb >> 9) & 1) << 5); R = (st >> 1) * 16 + swz / 64; C = (st & 1) * 32 + (swz % 64) / 2; }
__host__ __device__ __forceinline__ int perm32(int rho) { const int n = rho >> 4, i = rho & 15; return 8 * (i >> 2) + 4 * n + (i & 3); }
struct Unit { int pm, pn; };
struct Gemm { const bf16_t* A; const bf16_t* Bt; int M, N, K; int lda; int a_tiled; unsigned long long* dbg; };
struct StaticOrder {
    int nM, nN, nwg, G, c;
    __device__ void init(int M, int N, int G_, int c_) { nM = M / BM; nN = N / BM; nwg = nM * nN; G = G_; c = c_; }
    __device__ bool next(int i, Unit& u) const {
        const long L = (long)i * G + c; if (L >= nwg) return false;
        int wgid = (int)L; { const int q = nwg / NXCD, r = nwg % NXCD, xcd = wgid % NXCD, off = wgid / NXCD; wgid = (xcd < r ? xcd * (q + 1) : r * (q + 1) + (xcd - r) * q) + off; }
        const int nig = WGM * nN, gid = wgid / nig, fm = gid * WGM, gsz = (nM - fm) < WGM ? (nM - fm) : WGM;
        u.pm = fm + ((wgid % nig) % gsz); u.pn = (wgid % nig) / gsz; return true;
    }
};

typedef f32x4 Acc[2][2][4][2];

struct EpiSwiGLU {
    static constexpr bool PERM = true; static constexpr int MID_T = -1;
    bf16_t* O; const float* rs;
    __device__ __forceinline__ void mid(Acc&, const Unit&, int, int, int, int) const {}
    __device__ __forceinline__ void operator()(const Acc& acc, const Unit& u, int wr, int wc, int fr, int fq) const {
        int opq; asm volatile("v_mov_b32 %0, 0" : "=v"(opq));
        const int row0 = u.pm * BM + wr * 64 + fr + opq;
        float rsv[2][4];
#pragma unroll
        for (int ai = 0; ai < 2; ++ai)
#pragma unroll
            for (int m = 0; m < 4; ++m) rsv[ai][m] = rs ? rs[row0 + ai * HALF + m * 16] : 1.0f;
#pragma unroll
        for (int ai = 0; ai < 2; ++ai)
#pragma unroll
            for (int m = 0; m < 4; ++m) {
                bf16_t* rowp = O + tiled_off(row0 + ai * HALF + m * 16, u.pn * 128 + wc * 32 + 8 * fq, DFF / 64);
                float hv[8];
#pragma unroll
                for (int n = 0; n < 2; ++n)
#pragma unroll
                    for (int j = 0; j < 4; ++j) { const float g = acc[ai][0][m][n][j] * rsv[ai][m], up = acc[ai][1][m][n][j] * rsv[ai][m]; hv[4 * n + j] = g * fast_sigmoid(g) * up; }
                u32x4 w; w.x = pk2(hv[0], hv[1]); w.y = pk2(hv[2], hv[3]); w.z = pk2(hv[4], hv[5]); w.w = pk2(hv[6], hv[7]);
                *(u32x4*)rowp = w;
            }
    }
};
struct EpiHB {
    static constexpr bool PERM = true; static constexpr int MID_T = -1;
    const bf16_t* src; const float* srcinv; bf16_t* hb; float* ssq; float scale;
    __device__ __forceinline__ void mid(Acc&, const Unit&, int, int, int, int) const {}
    __device__ __forceinline__ void operator()(const Acc& acc, const Unit& u, int wr, int wc, int fr, int fq) const {
        int opq; asm volatile("v_mov_b32 %0, 0" : "=v"(opq));
        const int row0 = u.pm * BM + wr * 64 + fr + opq, col0 = u.pn * BM + wc * 32 + 8 * fq;
#pragma unroll
        for (int ai = 0; ai < 2; ++ai) {
            u32x4 bh[4][2]; float bs[4];
#pragma unroll
            for (int m = 0; m < 4; ++m) {
#pragma unroll
                for (int bj = 0; bj < 2; ++bj) bh[m][bj] = *(const u32x4*)(src + tiled_off(row0 + ai * HALF + m * 16, col0 + bj * HALF, DM / 64));
                bs[m] = srcinv ? srcinv[row0 + ai * HALF + m * 16] : 1.0f;
            }
            asm volatile("" ::: "memory");
#pragma unroll
            for (int m = 0; m < 4; ++m) {
                const float bsc = srcinv ? __builtin_amdgcn_rcpf(bs[m]) : 1.0f;
                float sq = 0.f;
#pragma unroll
                for (int bj = 0; bj < 2; ++bj) {
                    const u32x4 b = bh[m][bj];
                    f32x4 v0 = (f32x4){bf_lo(b.x), bf_hi(b.x), bf_lo(b.y), bf_hi(b.y)} * bsc, v1 = (f32x4){bf_lo(b.z), bf_hi(b.z), bf_lo(b.w), bf_hi(b.w)} * bsc;
                    v0 += acc[ai][bj][m][0] * scale; v1 += acc[ai][bj][m][1] * scale;
                    sq += (v0[0] * v0[0] + v0[1] * v0[1]) + (v0[2] * v0[2] + v0[3] * v0[3]) + (v1[0] * v1[0] + v1[1] * v1[1]) + (v1[2] * v1[2] + v1[3] * v1[3]);
                    u32x4 w; w.x = pk2(v0[0], v0[1]); w.y = pk2(v0[2], v0[3]); w.z = pk2(v1[0], v1[1]); w.w = pk2(v1[2], v1[3]);
                    *(u32x4*)(hb + tiled_off(row0 + ai * HALF + m * 16, col0 + bj * HALF, DM / 64)) = w;
                }
                sq += __shfl_xor(sq, 16); sq += __shfl_xor(sq, 32);
                if (fq == 0) ssq[(size_t)(row0 + ai * HALF + m * 16) * 16 + u.pn * 4 + wc] = sq;
            }
            asm volatile("" ::: "memory");
        }
    }
};
struct EpiZ {
    static constexpr bool PERM = true; static constexpr int MID_T = -1;
    bf16_t* O; const float* bias; const float* rs;
    __device__ __forceinline__ void mid(Acc&, const Unit&, int, int, int, int) const {}
    __device__ __forceinline__ void operator()(const Acc& acc, const Unit& u, int wr, int wc, int fr, int fq) const {
        int opq; asm volatile("v_mov_b32 %0, 0" : "=v"(opq));
        const int row0 = u.pm * BM + wr * 64 + fr + opq, col0 = u.pn * BM + wc * 32 + 8 * fq;
        float rsv[2][4];
#pragma unroll
        for (int ai = 0; ai < 2; ++ai)
#pragma unroll
            for (int m = 0; m < 4; ++m) rsv[ai][m] = rs[row0 + ai * HALF + m * 16];
        const bool isq = (u.pn < 3) || (u.pn == 9) || (u.pn == 10), isg = (u.pn >= 12);
        const int pn = u.pn; size_t bo; int ld, c0;
        if (pn < 3) { bo = ZO_QA; ld = 768; c0 = pn * 256; } else if (pn < 6) { bo = ZO_KA; ld = 768; c0 = (pn - 3) * 256; } else if (pn < 9) { bo = ZO_VA; ld = 768; c0 = (pn - 6) * 256; }
        else if (pn < 11) { bo = ZO_QB; ld = 512; c0 = (pn - 9) * 256; } else if (pn == 11) { bo = ZO_KVB; ld = 256; c0 = 0; } else { bo = ZO_G; ld = 2048; c0 = (pn - 12) * 256; }
        bf16_t* blk = O + bo; const int cb = c0 + wc * 32 + 8 * fq;
        const float sc = isq ? QSCALE : 1.0f;
        f32x4 bv[2][2];
#pragma unroll
        for (int bj = 0; bj < 2; ++bj)
#pragma unroll
            for (int n = 0; n < 2; ++n) bv[bj][n] = *(const f32x4*)(bias + col0 + bj * HALF + 4 * n);
#pragma unroll
        for (int ai = 0; ai < 2; ++ai)
#pragma unroll
            for (int m = 0; m < 4; ++m) {
                bf16_t* rowp = blk + (size_t)(row0 + ai * HALF + m * 16) * ld + cb;
#pragma unroll
                for (int bj = 0; bj < 2; ++bj) {
                    f32x4 v0 = (acc[ai][bj][m][0] * rsv[ai][m] + bv[bj][0]) * sc, v1 = (acc[ai][bj][m][1] * rsv[ai][m] + bv[bj][1]) * sc;
                    if (isg) {
                        unsigned q0 = 0, q1 = 0;
#pragma unroll
                        for (int j = 0; j < 4; ++j) { q0 = __builtin_amdgcn_cvt_pk_u8_f32(fast_sigmoid(v0[j]) * 255.0f, j, q0); q1 = __builtin_amdgcn_cvt_pk_u8_f32(fast_sigmoid(v1[j]) * 255.0f, j, q1); }
                        u32x2 w8; w8.x = q0; w8.y = q1;
                        *(u32x2*)((unsigned char*)(O + ZO_G) + (size_t)(row0 + ai * HALF + m * 16) * 2048 + c0 + wc * 32 + 8 * fq + bj * HALF) = w8;
                        continue;
                    }
                    u32x4 w; w.x = pk2(v0[0], v0[1]); w.y = pk2(v0[2], v0[3]); w.z = pk2(v1[0], v1[1]); w.w = pk2(v1[2], v1[3]);
                    *(u32x4*)(rowp + bj * HALF) = w;
                }
            }
    }
};
struct EpiMerge {
    static constexpr bool PERM = true; static constexpr int MID_T = 2;
    bf16_t* O; const bf16_t* Z;
    __device__ __forceinline__ void mid(Acc& acc, const Unit& u, int wr, int wc, int fr, int fq) const {
        int opq; asm volatile("v_mov_b32 %0, 0" : "=v"(opq));
        const int row0 = u.pm * BM + wr * 64 + fr + opq, col0 = u.pn * BM + wc * 32 + 8 * fq;
        const unsigned char* G8 = (const unsigned char*)(Z + ZO_G);
        u32x2 sa[2][4][2], sb[2][4][2];
#pragma unroll
        for (int ai = 0; ai < 2; ++ai)
#pragma unroll
            for (int m = 0; m < 4; ++m) {
                const unsigned char* zr = G8 + (size_t)(row0 + ai * HALF + m * 16) * 2048 + col0;
#pragma unroll
                for (int bj = 0; bj < 2; ++bj) { sa[ai][m][bj] = *(const u32x2*)(zr + bj * HALF); sb[ai][m][bj] = *(const u32x2*)(zr + 1024 + bj * HALF); }
            }
        asm volatile("" ::: "memory");
#pragma unroll
        for (int ai = 0; ai < 2; ++ai)
#pragma unroll
            for (int m = 0; m < 4; ++m)
#pragma unroll
                for (int bj = 0; bj < 2; ++bj)
#pragma unroll
                    for (int n = 0; n < 2; ++n)
#pragma unroll
                        for (int j = 0; j < 4; ++j) {
                            const float qa = (float)((sa[ai][m][bj][n] >> (8 * j)) & 255u), qb = fmaxf((float)((sb[ai][m][bj][n] >> (8 * j)) & 255u), 0.5f);
                            acc[ai][bj][m][n][j] *= qa * __builtin_amdgcn_rcpf(qb);
                        }
        asm volatile("" : "+v"(acc[0][0][0][0]), "+v"(acc[1][1][3][1]) :: "memory");
    }
    __device__ __forceinline__ void operator()(const Acc& acc, const Unit& u, int wr, int wc, int fr, int fq) const {
        const int row0 = u.pm * BM + wr * 64 + fr, col0 = u.pn * BM + wc * 32 + 8 * fq;
        const unsigned char* G8 = (const unsigned char*)(Z + ZO_G);
        u32x2 sbv[2][4][2];
#pragma unroll
        for (int ai = 0; ai < 2; ++ai)
#pragma unroll
            for (int m = 0; m < 4; ++m) {
                const unsigned char* zr = G8 + (size_t)(row0 + ai * HALF + m * 16) * 2048 + col0;
#pragma unroll
                for (int bj = 0; bj < 2; ++bj) sbv[ai][m][bj] = *(const u32x2*)(zr + 1024 + bj * HALF);
            }
        asm volatile("" ::: "memory");
#pragma unroll
        for (int ai = 0; ai < 2; ++ai)
#pragma unroll
            for (int m = 0; m < 4; ++m) {
                const int orow = row0 + ai * HALF + m * 16;
#pragma unroll
                for (int bj = 0; bj < 2; ++bj) {
                    float o[8];
#pragma unroll
                    for (int n = 0; n < 2; ++n)
#pragma unroll
                        for (int j = 0; j < 4; ++j) o[4 * n + j] = acc[ai][bj][m][n][j] * (fmaxf((float)((sbv[ai][m][bj][n] >> (8 * j)) & 255u), 0.5f) * (1.0f / 255.0f));
                    u32x4 w; w.x = pk2(o[0], o[1]); w.y = pk2(o[2], o[3]); w.z = pk2(o[4], o[5]); w.w = pk2(o[6], o[7]);
                    *(u32x4*)(O + tiled_off(orow, col0 + bj * HALF, DM / 64)) = w;
                }
            }
    }
};

template <class Epi, bool DBGP = false>
__device__ __forceinline__ void gemm_phase(LAS unsigned char* lds, const Gemm g, const StaticOrder& S, const Epi& E) {
    int tid_o = threadIdx.x; asm volatile("" : "+v"(tid_o));
    const int tid = tid_o, wid = __builtin_amdgcn_readfirstlane(tid >> 6), lane = tid & 63, wr = wid >> 2, wc = wid & 3, fr = lane & 15, fq = lane >> 4;
    const int K = g.K, nt = K / BK;
    unsigned voffA[2], voffB[2];
#pragma unroll
    for (int i = 0; i < 2; ++i) { int R, C; stage_rc(tid * 16 + i * 8192, R, C); const int Rb = Epi::PERM ? ((R & ~31) + perm32(R & 31)) : R;
        (void)Rb; voffA[i] = g.a_tiled ? (unsigned)(tid * 16 + i * 8192) : (unsigned)(R * g.lda + C) * 2u; voffB[i] = (unsigned)(tid * 16 + i * 8192); }
    const size_t kstep = (size_t)(BM * BK * 2);
    const size_t hstep = (size_t)(HALF * BK * 2);
    const size_t tstep = (size_t)BM * K * 2;
    const size_t kstepA = g.a_tiled ? kstep : (size_t)(BK * 2), hstepA = g.a_tiled ? hstep : (size_t)HALF * g.lda * 2;
    const size_t tstepA = g.a_tiled ? tstep : 2 * hstepA;
    const unsigned ldsw = (unsigned)wid * 1024u;
    const int aoff = lds_byte(wr * 64 + fr, fq * 8), boff = lds_byte(wc * 32 + fr, fq * 8);
#define PG8_SA(b, h) (((b) * 2 + (h)) * HTB)
#define PG8_SB(b, h) ((4 + (b) * 2 + (h)) * HTB)
#define PG8_STAGE(bufoff, gbase, voff) do { _Pragma("unroll") for (int _i = 0; _i < 2; ++_i) \
        __builtin_amdgcn_global_load_lds((const unsigned*)((const char*)(gbase) + (voff)[_i]), (LAS unsigned*)(lds + (bufoff) + ldsw + _i * 8192), 16, 0, 0); } while (0)
#define PG8_LDA(dst, b, h) do { _Pragma("unroll") for (int m = 0; m < 4; ++m) _Pragma("unroll") for (int k = 0; k < 2; ++k) dst[m][k] = *(const LAS bf16x8*)(lds + PG8_SA(b, h) + aoff + m * 2048 + k * 1024); } while (0)
#define PG8_LDB(dst, b, h) do { _Pragma("unroll") for (int n = 0; n < 2; ++n) _Pragma("unroll") for (int k = 0; k < 2; ++k) dst[n][k] = *(const LAS bf16x8*)(lds + PG8_SB(b, h) + boff + n * 2048 + k * 1024); } while (0)
#define PG8_MMA(ai, bj, At, Bt) do { __builtin_amdgcn_s_setprio(1); _Pragma("unroll") for (int m = 0; m < 4; ++m) _Pragma("unroll") for (int n = 0; n < 2; ++n) _Pragma("unroll") for (int k = 0; k < 2; ++k) \
        acc[ai][bj][m][n] = __builtin_amdgcn_mfma_f32_16x16x32_bf16(Bt[n][k], At[m][k], acc[ai][bj][m][n], 0, 0, 0); __builtin_amdgcn_s_setprio(0); } while (0)
#define PG8_WAIT_V(n) asm volatile("s_waitcnt vmcnt(" #n ")" ::: "memory")
#define PG8_WAIT_L(n) asm volatile("s_waitcnt lgkmcnt(" #n ")" ::: "memory")
#define PG8_BAR __builtin_amdgcn_s_barrier()
#define PG8_SCHED __builtin_amdgcn_sched_barrier(0)
#ifndef DBG_GEMM_MODE
#define DBG_GEMM_MODE 0
#endif
    unsigned long long dbg_acc = 0, dbg_t0 = 0; (void)dbg_t0;
    Unit cur, nxt; int ui = 0;
    if (!S.next(0, cur)) return;
    Acc acc;
#pragma unroll
    for (int a = 0; a < 2; ++a)
#pragma unroll
        for (int b = 0; b < 2; ++b)
#pragma unroll
            for (int m = 0; m < 4; ++m)
#pragma unroll
                for (int n = 0; n < 2; ++n) acc[a][b][m][n] = (f32x4){0.f, 0.f, 0.f, 0.f};
    bf16x8 At[4][2], B0[2][2], B1[2][2];
    const char* cA = uni_ptr((const char*)g.A + (size_t)cur.pm * tstepA); const char* cB = uni_ptr((const char*)g.Bt + (size_t)cur.pn * tstep);
    PG8_STAGE(PG8_SB(0, 0), cB, voffB); PG8_STAGE(PG8_SB(0, 1), cB + hstep, voffB); PG8_STAGE(PG8_SA(0, 0), cA, voffA); PG8_STAGE(PG8_SA(0, 1), cA + hstepA, voffA);
    if (wr == 1) PG8_BAR;
    PG8_WAIT_V(2); PG8_BAR;
    PG8_STAGE(PG8_SB(1, 0), cB + kstep, voffB); PG8_STAGE(PG8_SA(1, 0), cA + kstepA, voffA); PG8_STAGE(PG8_SB(1, 1), cB + hstep + kstep, voffB);
    PG8_WAIT_V(6); PG8_BAR;
    for (;;) {
        const bool has_next = S.next(ui + 1, nxt);
        const char* nA = uni_ptr(has_next ? (const char*)g.A + (size_t)nxt.pm * tstepA : cA); const char* nB = uni_ptr(has_next ? (const char*)g.Bt + (size_t)nxt.pn * tstep : cB);
        if (DBG_GEMM_MODE == 3 && DBGP) dbg_t0 = __builtin_amdgcn_s_memrealtime();
        if (DBG_GEMM_MODE == 5 && DBGP && ui > 0) dbg_acc += __builtin_amdgcn_s_memrealtime() - dbg_t0;
        for (int t = 0; t < nt; t += 2) {
            if (DBG_GEMM_MODE == 2 && DBGP && t == 2) dbg_t0 = __builtin_amdgcn_s_memrealtime();
            if (DBG_GEMM_MODE == 3 && DBGP && t == 2) dbg_acc += __builtin_amdgcn_s_memrealtime() - dbg_t0;
            const bool last = (t == nt - 2);
            const char* a1 = cA + (size_t)(t + 1) * kstepA;
            const char* a2 = last ? nA : cA + (size_t)(t + 2) * kstepA; const char* b2 = last ? nB : cB + (size_t)(t + 2) * kstep;
            const char* a3 = a2 + kstepA; const char* b3 = b2 + kstep;
            PG8_LDB(B0, 0, 0); PG8_LDB(B1, 0, 1); PG8_SCHED; PG8_LDA(At, 0, 0); PG8_STAGE(PG8_SA(1, 1), a1 + hstepA, voffA);
            PG8_WAIT_V(8); PG8_WAIT_L(0); PG8_BAR; PG8_MMA(0, 0, At, B0); PG8_MMA(0, 1, At, B1); PG8_BAR; PG8_SCHED;
            PG8_LDA(At, 0, 1); PG8_STAGE(PG8_SB(0, 0), b2, voffB); PG8_STAGE(PG8_SB(0, 1), b2 + hstep, voffB); PG8_STAGE(PG8_SA(0, 0), a2, voffA);
            PG8_WAIT_V(8); PG8_WAIT_L(0); PG8_BAR; PG8_MMA(1, 0, At, B0); PG8_MMA(1, 1, At, B1); PG8_BAR; PG8_SCHED;
            PG8_LDB(B0, 1, 0); PG8_LDB(B1, 1, 1); PG8_SCHED; PG8_LDA(At, 1, 0); PG8_STAGE(PG8_SA(0, 1), a2 + hstepA, voffA);
            PG8_WAIT_V(8); PG8_WAIT_L(0); PG8_BAR; PG8_MMA(0, 0, At, B0); PG8_MMA(0, 1, At, B1); PG8_BAR; PG8_SCHED;
            PG8_LDA(At, 1, 1); PG8_STAGE(PG8_SB(1, 0), b3, voffB); PG8_STAGE(PG8_SB(1, 1), b3 + hstep, voffB); PG8_STAGE(PG8_SA(1, 0), a3, voffA);
            PG8_WAIT_V(8); PG8_WAIT_L(0); PG8_BAR; PG8_MMA(1, 0, At, B0); PG8_MMA(1, 1, At, B1); PG8_BAR; PG8_SCHED;
            if constexpr (Epi::MID_T >= 0) { if (t == Epi::MID_T) { E.mid(acc, cur, wr, wc, fr, fq); PG8_SCHED; } }
        }
        if (DBG_GEMM_MODE == 2 && DBGP) dbg_acc += __builtin_amdgcn_s_memrealtime() - dbg_t0;
        if (DBG_GEMM_MODE == 5 && DBGP) dbg_t0 = __builtin_amdgcn_s_memrealtime();
        if (wr == 0) PG8_BAR;
        if (DBG_GEMM_MODE == 1 && DBGP) dbg_t0 = __builtin_amdgcn_s_memrealtime();
        E(acc, cur, wr, wc, fr, fq);
#ifdef DBG_EPI2
        if (DBGP) { asm volatile("" ::: "memory"); E(acc, cur, wr, wc, fr, fq); }
#endif
        if (DBG_GEMM_MODE == 1 && DBGP) dbg_acc += __builtin_amdgcn_s_memrealtime() - dbg_t0;
        if (!has_next) break;
#pragma unroll
        for (int a = 0; a < 2; ++a)
#pragma unroll
            for (int b = 0; b < 2; ++b)
#pragma unroll
                for (int m = 0; m < 4; ++m)
#pragma unroll
                    for (int n = 0; n < 2; ++n) acc[a][b][m][n] = (f32x4){0.f, 0.f, 0.f, 0.f};
        cur = nxt; cA = nA; cB = nB; ++ui;
        if (wr == 1) PG8_BAR;
    }
    PG8_WAIT_V(0);
    PG8_BAR;
    if (DBG_GEMM_MODE && DBGP && blockIdx.x == 0 && tid == 0) *g.dbg = dbg_acc;
#undef PG8_SA
#undef PG8_SB
#undef PG8_STAGE
#undef PG8_LDA
#undef PG8_LDB
#undef PG8_MMA
#undef PG8_WAIT_V
#undef PG8_WAIT_L
#undef PG8_BAR
#undef PG8_SCHED
}
}

#define XB_TMO      128
#define XB_XCNT(j)  (256  + 64 * (j))
#define XB_XSUB(j)  (1280 + 64 * (j))
#define XB_XGEN(j)  (2304 + 64 * (j))
#define XB_TOP      3328
#define XB_TOPGEN   3392
#define XCD_BAR_WORDS 3456
#define XB_SPIN_CAP (1u << 18)

__device__ __forceinline__ unsigned xb_ld(unsigned* p)              { return __hip_atomic_load(p, __ATOMIC_RELAXED, __HIP_MEMORY_SCOPE_AGENT); }
__device__ __forceinline__ unsigned xb_add(unsigned* p, unsigned v) { return __hip_atomic_fetch_add(p, v, __ATOMIC_RELAXED, __HIP_MEMORY_SCOPE_AGENT); }
__device__ __forceinline__ unsigned xb_xcc_id() { return (unsigned)__builtin_amdgcn_s_getreg((3 << 11) | 20) & 0xFu; }
#define XB_SPIN(cond, bar) do { unsigned _sp = 0; while (cond) { __builtin_amdgcn_s_sleep(1); \
    if ((++_sp & 255u) == 0u) { if (xb_ld(&(bar)[XB_TMO])) break; if (_sp > XB_SPIN_CAP) { atomicAdd(&(bar)[XB_TMO], 1u); break; } } } } while (0)

struct XcdBarrier {
    unsigned* bar; unsigned x;
    volatile LAS unsigned* st;
};

__device__ __forceinline__ XcdBarrier xcd_barrier_post(unsigned* bar, volatile LAS unsigned* st) {
    XcdBarrier b; b.bar = bar; b.x = xb_xcc_id(); b.st = st;
    if (threadIdx.x == 0) (void)xb_add(&bar[XB_XCNT(b.x)], 1u);
    return b;
}
__device__ __forceinline__ void xcd_barrier_complete(unsigned* bar, unsigned x, unsigned& nloc, unsigned& nx) {
    const unsigned G = gridDim.x * gridDim.y * gridDim.z;
    unsigned sum, cnt, mine, sp = 0u;
    for (;;) {
        sum = 0u; cnt = 0u; mine = 0u;
#pragma unroll
        for (unsigned j = 0; j < 16; ++j) { const unsigned c = xb_ld(&bar[XB_XCNT(j)]); sum += c; cnt += (c > 0u) ? 1u : 0u; mine = (j == x) ? c : mine; }
        if (sum == G) break;
        __builtin_amdgcn_s_sleep(1);
        if ((++sp & 255u) == 0u) { if (xb_ld(&bar[XB_TMO])) break; if (sp > XB_SPIN_CAP) { atomicAdd(&bar[XB_TMO], 1u); break; } }
    }
    nloc = mine > 0u ? mine : 1u; nx = cnt > 0u ? cnt : 1u;
}

__device__ __forceinline__ void xcd_barrier(const XcdBarrier& b) {
    asm volatile("s_waitcnt vmcnt(0)" ::: "memory");
    __syncthreads();
    if (threadIdx.x == 0) {
        unsigned* bar = b.bar;
        __builtin_amdgcn_s_waitcnt(0);
        unsigned nloc = b.st[0], nx = b.st[1];
        if (nloc == 0u) { xcd_barrier_complete(bar, b.x, nloc, nx); b.st[0] = nloc; b.st[1] = nx; }
        const unsigned old = xb_add(&bar[XB_XSUB(b.x)], 1u);
        const unsigned gen = old / nloc;
        if (old + 1u == (gen + 1u) * nloc) {
            __builtin_amdgcn_fence(__ATOMIC_RELEASE, "agent");
            asm volatile("s_waitcnt vmcnt(0)" ::: "memory");
            const unsigned og = xb_add(&bar[XB_TOP], 1u);
            const unsigned tg = og / nx;
            if (og + 1u == (tg + 1u) * nx) xb_add(&bar[XB_TOPGEN], 1u);
            else XB_SPIN(xb_ld(&bar[XB_TOPGEN]) == tg, bar);
            __builtin_amdgcn_fence(__ATOMIC_ACQUIRE, "agent");
            xb_add(&bar[XB_XGEN(b.x)], 1u);
            asm volatile("s_waitcnt vmcnt(0)" ::: "memory");
        } else {
            XB_SPIN(xb_ld(&bar[XB_XGEN(b.x)]) == gen, bar);
            __builtin_amdgcn_fence(__ATOMIC_ACQUIRE, "agent");
            asm volatile("s_waitcnt vmcnt(0)" ::: "memory");
        }
    }
    __syncthreads();
}


__device__ __forceinline__ int otid() { int t = threadIdx.x; asm volatile("" : "+v"(t)); return t; }
__device__ __forceinline__ float wave_sum(float v) {
#pragma unroll
    for (int o = 1; o < 64; o <<= 1) v += __shfl_xor(v, o);
    return v;
}
__device__ __forceinline__ void transpose_item(const float* W, int N, const float* gain, bf16_t* WT, int ldk, int koff, int drow0, int k0, int n0, LAS float* scr, int lane) {
    const f32x4* src = (const f32x4*)(W + (size_t)(k0 + lane) * N + n0);
    f32x4 v[8];
#pragma unroll
    for (int j = 0; j < 8; ++j) v[j] = src[j];
    const float gsc = gain ? gain[k0 + lane] : 1.0f;
#pragma unroll
    for (int j = 0; j < 8; ++j) { scr[lane * 33 + 4 * j + 0] = v[j].x * gsc; scr[lane * 33 + 4 * j + 1] = v[j].y * gsc; scr[lane * 33 + 4 * j + 2] = v[j].z * gsc; scr[lane * 33 + 4 * j + 3] = v[j].w * gsc; }
    asm volatile("s_waitcnt lgkmcnt(0)" ::: "memory");
    const int c = lane & 7;
#pragma unroll
    for (int j = 0; j < 4; ++j) { const int n = (lane >> 3) + 8 * j; const LAS float* sp = scr + (8 * c) * 33 + n;
        u32x4 o; o.x = pk2(sp[0 * 33], sp[1 * 33]); o.y = pk2(sp[2 * 33], sp[3 * 33]); o.z = pk2(sp[4 * 33], sp[5 * 33]); o.w = pk2(sp[6 * 33], sp[7 * 33]);
        *(u32x4*)(WT + tiled_off(wslot(drow0 + n), koff + k0 + 8 * c, ldk >> 6)) = o; }
    asm volatile("s_waitcnt lgkmcnt(0)" ::: "memory");
}

struct Params {
    const float* in[18];
    float* out;
    unsigned char* ws;
};

__device__ __forceinline__ void norm_rows_bf16(const float* src, bf16_t* dst, float* rsout, int gw, int ngw, int lane) {
    for (int m = 4 * gw; m < MTOK; m += 4 * ngw) {
        const f32x4* xr = (const f32x4*)(src + (size_t)m * DM) + lane;
        f32x4 v[4][4]; float ss[4];
#pragma unroll
        for (int q = 0; q < 4; ++q)
#pragma unroll
            for (int j = 0; j < 4; ++j) v[q][j] = xr[256 * q + 64 * j];
#pragma unroll
        for (int q = 0; q < 4; ++q) { float a = 0.f;
#pragma unroll
            for (int j = 0; j < 4; ++j) a += (v[q][j].x * v[q][j].x + v[q][j].y * v[q][j].y) + (v[q][j].z * v[q][j].z + v[q][j].w * v[q][j].w);
            ss[q] = a; }
#pragma unroll
        for (int o = 1; o < 64; o <<= 1) {
#pragma unroll
            for (int q = 0; q < 4; ++q) ss[q] += __shfl_xor(ss[q], o);
        }
#pragma unroll
        for (int q = 0; q < 4; ++q) {
            const float r = 1.0f / sqrtf(ss[q] * (1.0f / DM) + EPS);
            if (lane == 0) rsout[m + q] = r;
#pragma unroll
            for (int j = 0; j < 4; ++j) { u32x2 w; w.x = pk2(v[q][j].x * r, v[q][j].y * r); w.y = pk2(v[q][j].z * r, v[q][j].w * r); *(u32x2*)(dst + tiled_off(m + q, 4 * lane + 256 * j, DM / 64)) = w; }
        }
    }
}
__device__ __forceinline__ void rowscale_phase(const float* ssq, float* rs, int gtid, int nth) {
    for (int row = gtid; row < MTOK; row += nth) {
        const f32x4* pp = (const f32x4*)(ssq + (size_t)row * 16);
        const f32x4 a = pp[0], b = pp[1], c = pp[2], d = pp[3];
        const float sum = ((a.x + a.y) + (a.z + a.w)) + ((b.x + b.y) + (b.z + b.w)) + ((c.x + c.y) + (c.z + c.w)) + ((d.x + d.y) + (d.z + d.w));
        rs[row] = 1.0f / sqrtf(sum * (1.0f / DM) + EPS);
    }
}

__device__ __forceinline__ void attn_load_block(LAS unsigned char* lds, const bf16_t* kp0, const bf16_t* vp0, int kvld, int tokbase, int d, int blk, int tid) {
    const int ch = tid & 7, rw = tid >> 3;
    u32x4 tmp[8];
#pragma unroll
    for (int i = 0; i < 8; ++i) { const int mat = i >> 1, row = rw + 64 * (i & 1); const int tok = tokbase + d * (blk * 128 + row);
        tmp[i] = *(const u32x4*)(((mat < 2) ? kp0 : vp0) + (size_t)tok * kvld + (mat & 1) * 64 + ch * 8); }
#pragma unroll
    for (int i = 0; i < 8; ++i) { const int mat = i >> 1, row = (blk & 1) * 128 + rw + 64 * (i & 1); *(LAS u32x4*)(lds + mat * 36864 + row * 144 + ch * 16) = tmp[i]; }
}
#define ATT_BAR() do { asm volatile("s_waitcnt lgkmcnt(0)" ::: "memory"); __builtin_amdgcn_s_barrier(); asm volatile("" ::: "memory"); } while (0)
__device__ __forceinline__ void attn_phase(LAS unsigned char* lds, bf16_t* Z, bf16_t* YAB, float* LSE, const float* lutg, const float* sinks, int G, int wg) {
    int tid_o = threadIdx.x; asm volatile("" : "+v"(tid_o));
    const int tid = tid_o, wv = __builtin_amdgcn_readfirstlane(tid >> 6), lane = tid & 63, r = lane & 31, h = lane >> 5;
    LAS float* lutl = (LAS float*)(lds + 147456);
    for (int sid = wg; sid < 1792; sid += G) {
        int isB, gi, d, hp, bt, rs, b0, len;
        if (sid < 256) { isB = 0; gi = 0; d = 1; const int chain = sid >> 2; hp = chain & 1; bt = chain >> 1; rs = 0; b0 = (sid & 3) * 4; len = 4; }
        else if (sid < 512) { const int c = sid - 256; isB = 0; gi = 1; d = 4; hp = c & 1; const int seq = c >> 1; bt = seq >> 2; rs = seq & 3; b0 = 0; len = 4; }
        else if (sid < 1536) { const int c = sid - 512; isB = 0; gi = 2; d = 16; hp = c & 1; const int seq = c >> 1; bt = seq >> 4; rs = seq & 15; b0 = 0; len = 1; }
        else { const int c = sid - 1536; isB = 1; gi = 0; d = 1; hp = 0; bt = c >> 3; rs = 0; b0 = (c & 7) * 2; len = 2; }
        const int tokbase = bt * SEQ + rs;
        const bf16_t* kp0 = isB ? (Z + ZO_KVB) : (Z + ZO_KA + (4 * gi + 2 * hp) * 64); const bf16_t* vp0 = isB ? (Z + ZO_KVB + 128) : (Z + ZO_VA + (4 * gi + 2 * hp) * 64);
        const int kvld = isB ? 256 : 768, qld = isB ? 512 : 768;
        for (int b = b0; b < b0 + len; ++b) {
        ATT_BAR();
        if (b == b0) {
            if (b0 > 0) attn_load_block(lds, kp0, vp0, kvld, tokbase, d, b0 - 1, tid);
            const int nh = isB ? 8 : 2, headbase = isB ? 12 : 4 * gi + 2 * hp;
            for (int idx = tid; idx < nh * LUTP; idx += 512) lutl[idx] = lutg[headbase * LUTP + idx];
        }
        attn_load_block(lds, kp0, vp0, kvld, tokbase, d, b, tid);
        ATT_BAR();
        const int nrounds = isB ? 4 : 1;
        for (int rd = 0; rd < nrounds; ++rd) {
            int slot, rt, qcol, lh, qh = 0; float sink = NEGBIG;
            if (!isB) { slot = wv >> 2; rt = wv & 3; qcol = (4 * gi + 2 * hp + slot) * 64; lh = slot; }
            else { const int tk = rd * 8 + wv; qh = tk >> 2; rt = tk & 3; slot = qh >> 2; qcol = qh * 64; lh = qh; sink = sinks[qh] * LOG2E; }
            bf16_t* qbase = Z + (isB ? ZO_QB : ZO_QA) + qcol;
            const int qi = 32 * rt + r;
            const size_t qtok = (size_t)(tokbase + d * (b * 128 + qi));
            const bf16_t* qp = qbase + qtok * qld + 8 * h;
            bf16x8 qf[4];
#pragma unroll
            for (int s = 0; s < 4; ++s) qf[s] = *(const bf16x8*)(qp + 16 * s);
            const LAS unsigned char* Ks = lds + slot * 36864;
            const LAS unsigned char* Vs = lds + 73728 + slot * 36864;
            const int dk_start = (b == 0) ? ((4 - rt) > 0 ? (4 - rt) : 0) : 0;
            f32x16 X[5];
            if (dk_start == 0) {
#pragma unroll
                for (int dk = 0; dk < 5; ++dk) {
                    const LAS float* lp = lutl + lh * LUTP + 32 + 128 - 32 * dk + r - 4 * h;
#pragma unroll
                    for (int i = 0; i < 16; ++i) X[dk][i] = lp[-((i & 3) + 8 * (i >> 2))];
                }
#pragma unroll
                for (int s = 0; s < 4; ++s) {
                    bf16x8 kf[5];
#pragma unroll
                    for (int dk = 0; dk < 5; ++dk) { const int kt = rt + dk; const int lrow = (((b - 1 + (kt >> 2)) & 1) << 7) + ((kt & 3) << 5);
                        kf[dk] = *(const LAS bf16x8*)(Ks + (lrow + r) * 144 + 16 * h + 32 * s); }
#pragma unroll
                    for (int dk = 0; dk < 5; ++dk) X[dk] = __builtin_amdgcn_mfma_f32_32x32x16_bf16(kf[dk], qf[s], X[dk], 0, 0, 0);
                }
            } else {
#pragma unroll
            for (int dk = 0; dk < 5; ++dk) {
                if (dk >= dk_start) {
                    const int kt = rt + dk;
                    const int lrow = (((b - 1 + (kt >> 2)) & 1) << 7) + ((kt & 3) << 5);
                    const LAS unsigned char* kp = Ks + (lrow + r) * 144 + 16 * h;
                    const LAS float* lp = lutl + lh * LUTP + 32 + 128 - 32 * dk + r - 4 * h;
                    f32x16 x;
#pragma unroll
                    for (int i = 0; i < 16; ++i) x[i] = lp[-((i & 3) + 8 * (i >> 2))];
                    bf16x8 kf[4];
#pragma unroll
                    for (int s = 0; s < 4; ++s) kf[s] = *(const LAS bf16x8*)(kp + 32 * s);
#pragma unroll
                    for (int s = 0; s < 4; ++s) x = __builtin_amdgcn_mfma_f32_32x32x16_bf16(kf[s], qf[s], x, 0, 0, 0);
                    X[dk] = x;
                } else {
#pragma unroll
                    for (int i = 0; i < 16; ++i) X[dk][i] = NEGBIG;
                }
            }
            }
            float mxp[4] = {NEGBIG, NEGBIG, NEGBIG, NEGBIG};
#pragma unroll
            for (int dk = 0; dk < 5; ++dk)
#pragma unroll
                for (int i = 0; i < 16; ++i) mxp[i & 3] = fmaxf(mxp[i & 3], X[dk][i]);
            float mx = fmaxf(fmaxf(mxp[0], mxp[1]), fmaxf(mxp[2], mxp[3]));
            mx = fmaxf(mx, __shfl_xor(mx, 32));
            mx = fmaxf(mx, sink);
            float lp4[4] = {0.f, 0.f, 0.f, 0.f};
#pragma unroll
            for (int dk = 0; dk < 5; ++dk)
#pragma unroll
                for (int i = 0; i < 16; ++i) { const float p = __builtin_amdgcn_exp2f(X[dk][i] - mx); X[dk][i] = p; lp4[i & 3] += p; }
            float l = (lp4[0] + lp4[1]) + (lp4[2] + lp4[3]);
            l += __shfl_xor(l, 32);
            if (isB) l += __builtin_amdgcn_exp2f(sink - mx);
            f32x16 O[2];
#pragma unroll
            for (int i = 0; i < 16; ++i) { O[0][i] = 0.f; O[1][i] = 0.f; }
            const int i16 = lane & 15, tq = i16 >> 2, tp = i16 & 3;
            const LAS unsigned char* vbase = Vs + (4 * h + tq) * 144 + 32 * ((lane >> 4) & 1) + 8 * tp;
#pragma unroll
            for (int dk = 0; dk < 5; ++dk) {
                if (dk >= dk_start) {
                    const int kt = rt + dk;
                    const int lrow = (((b - 1 + (kt >> 2)) & 1) << 7) + ((kt & 3) << 5);
#pragma unroll
                    for (int s = 0; s < 2; ++s) {
                        u32x4 pw; pw.x = pk2(X[dk][8 * s + 0], X[dk][8 * s + 1]); pw.y = pk2(X[dk][8 * s + 2], X[dk][8 * s + 3]); pw.z = pk2(X[dk][8 * s + 4], X[dk][8 * s + 5]); pw.w = pk2(X[dk][8 * s + 6], X[dk][8 * s + 7]);
                        const bf16x8 pf = __builtin_bit_cast(bf16x8, pw);
#pragma unroll
                        for (int dt = 0; dt < 2; ++dt) {
                            const LAS unsigned char* va = vbase + (lrow + 16 * s) * 144 + 64 * dt;
                            const s16x4 lo = __builtin_amdgcn_ds_read_tr16_b64_v4i16((LAS s16x4*)(va));
                            const s16x4 hi = __builtin_amdgcn_ds_read_tr16_b64_v4i16((LAS s16x4*)(va + 8 * 144));
                            const bf16x8 vf = __builtin_shufflevector(lo, hi, 0, 1, 2, 3, 4, 5, 6, 7);
                            O[dt] = __builtin_amdgcn_mfma_f32_32x32x16_bf16(vf, pf, O[dt], 0, 0, 0);
                        }
                    }
                }
            }
            const float inv = 1.0f / l;
            bf16_t* op = qbase + qtok * qld;
#pragma unroll
            for (int dt = 0; dt < 2; ++dt)
#pragma unroll
                for (int pr = 0; pr < 2; ++pr) {
                    const int ga = 2 * pr, gb = 2 * pr + 1;
                    const unsigned x0 = pk2(O[dt][4 * ga] * inv, O[dt][4 * ga + 1] * inv), x1 = pk2(O[dt][4 * ga + 2] * inv, O[dt][4 * ga + 3] * inv);
                    const unsigned y0 = pk2(O[dt][4 * gb] * inv, O[dt][4 * gb + 1] * inv), y1 = pk2(O[dt][4 * gb + 2] * inv, O[dt][4 * gb + 3] * inv);
                    const u32x2 s0 = __builtin_amdgcn_permlane32_swap(x0, y0, false, false), s1 = __builtin_amdgcn_permlane32_swap(x1, y1, false, false);
                    u32x4 w; w.x = s0.x; w.y = s1.x; w.z = s0.y; w.w = s1.y;
                    if (isB) *(u32x4*)(YAB + tiled_off((int)qtok, 256 + qcol + 32 * dt + 8 * (2 * pr + h), 12)) = w;
                    else *(u32x4*)(op + 32 * dt + 8 * (2 * pr + h)) = w;
                }
            if (!isB && h == 0) LSE[((size_t)gi * MTOK + qtok) * 4 + 2 * hp + slot] = mx + __builtin_amdgcn_logf(l);
        }
        }
    }
}

__device__ __forceinline__ void combine_phase(const bf16_t* Z, const float* LSE, bf16_t* YAB, int gtid, int nth) {
    for (int idx = gtid; idx < MTOK * 32; idx += nth) {
        const int tok = idx >> 5; const int c = (int)(idx & 31), s = c >> 3, e0 = (c & 7) * 8;
        const float l0 = LSE[((size_t)0 * MTOK + tok) * 4 + s], l1 = LSE[((size_t)1 * MTOK + tok) * 4 + s], l2 = LSE[((size_t)2 * MTOK + tok) * 4 + s];
        const float mx = fmaxf(l0, fmaxf(l1, l2));
        const float w0 = __builtin_amdgcn_exp2f(l0 - mx), w1 = __builtin_amdgcn_exp2f(l1 - mx), w2 = __builtin_amdgcn_exp2f(l2 - mx);
        const float inv = 1.0f / (w0 + w1 + w2);
        const float a0 = w0 * inv, a1 = w1 * inv, a2 = w2 * inv;
        const bf16_t* zr = Z + ZO_QA + (size_t)tok * 768 + s * 64 + e0;
        const u32x4 o0 = *(const u32x4*)(zr), o1 = *(const u32x4*)(zr + 256), o2 = *(const u32x4*)(zr + 512);
        u32x4 w;
#pragma unroll
        for (int q = 0; q < 4; ++q) {
            const float lo = a0 * bf_lo(o0[q]) + a1 * bf_lo(o1[q]) + a2 * bf_lo(o2[q]);
            const float hi = a0 * bf_hi(o0[q]) + a1 * bf_hi(o1[q]) + a2 * bf_hi(o2[q]);
            w[q] = pk2(lo, hi);
        }
        *(u32x4*)(YAB + tiled_off(tok, s * 64 + e0, 12)) = w;
    }
}

#ifndef DBG_A
#define DBG_A -1
#endif
#ifndef DBG_B
#define DBG_B -1
#endif
#ifndef DBG_DOUBLE
#define DBG_DOUBLE -1
#endif
#ifndef DBG_GEMM_PHASE
#define DBG_GEMM_PHASE -1
#endif
#define GDBG(k) ((DBG_GEMM_PHASE == (k)) ? (unsigned long long*)(p.ws + MiB) + 20 : (unsigned long long*)nullptr)
#define REP(k) for (int rep_ = 0; rep_ < ((DBG_DOUBLE == (k)) ? 2 : 1); ++rep_)
#define TSTAMP(k) do { if (DBG_A >= 0 && wg == 0 && threadIdx.x == 0) { ((unsigned long long*)(p.ws + MiB))[k] = __builtin_amdgcn_s_memrealtime(); ((unsigned long long*)(p.ws + MiB))[32 + k] = __builtin_amdgcn_s_memtime(); } } while (0)
#ifndef PHASE_MASK
#define PHASE_MASK 0xFFFFu
#endif
#define PH(k) ((PHASE_MASK >> (k)) & 1u)

__global__ void __launch_bounds__(512, 2) fwd_kernel(Params p) {
    extern __shared__ __attribute__((aligned(16))) unsigned char lds_raw[];
    LAS unsigned char* lds = (LAS unsigned char*)lds_raw;
    cg::grid_group grid = cg::this_grid();
    const int G = gridDim.x, wg = blockIdx.x, ngw = G * 8;
    if (threadIdx.x < 16) ((LAS unsigned*)(lds + LDS_CTL_OFF))[threadIdx.x] = 0u;
    __syncthreads();
    const XcdBarrier xbar = xcd_barrier_post((unsigned*)p.ws, (volatile LAS unsigned*)(lds + LDS_CTL_OFF));
#define PHASE_IDS const int tid = otid(), lane = tid & 63, wave = __builtin_amdgcn_readfirstlane(tid >> 6), gw = wg * 8 + wave; (void)lane; (void)gw;
#define Wgu1 ((bf16_t*)(p.ws + WS_WGU1))
#define Wd1 ((bf16_t*)(p.ws + WS_WD1))
#define Win ((bf16_t*)(p.ws + WS_WIN))
#define Wbr ((bf16_t*)(p.ws + WS_WBR))
#define Wout ((bf16_t*)(p.ws + WS_WOUT))
#define Wgu2 ((bf16_t*)(p.ws + WS_WGU2))
#define Wd2 ((bf16_t*)(p.ws + WS_WD2))
#define lutg ((float*)(p.ws + WS_LUT))
#define LSE ((float*)(p.ws + WS_LSE))
#define XN ((bf16_t*)(p.ws + WS_XN))
#define HB ((bf16_t*)(p.ws + WS_HB))
#define RS ((float*)(p.ws + WS_RS))
#define SSQ ((float*)(p.ws + WS_SSQ))
#define YAB ((bf16_t*)(p.ws + WS_XN))
#define Z ((bf16_t*)(p.ws + WS_Z))
#define HID ((bf16_t*)(p.ws + WS_Z))

    TSTAMP(0);
#ifdef DBG_XCC
    if (wg == 0 && threadIdx.x == 0) *((unsigned*)(p.ws + MiB + 4096)) = 0u;
#endif
    REP(0) if (PH(0)) {
        PHASE_IDS
        LAS float* scr = (LAS float*)(lds + wave * 16384);
        constexpr int I_GU = 16 * 88, I_DN = 44 * 32, I_IN = 16 * 160, I_BA = 4 * 32, I_BB = 8 * 32, I_OUT = 16 * 32;
        constexpr int NITEMS = 6 * I_GU + I_IN + I_BA + I_BB + I_OUT;
        for (int it = gw; it < NITEMS; it += ngw) {
            int rr = it;
            bool done = false;
#pragma unroll
            for (int f = 0; f < 4; ++f) {
                if (!done && rr < I_GU) { const int kb = rr / 88, nb = rr % 88, n0 = nb * 32; const int which = f & 1, layer = f >> 1;
                    const float* W = p.in[layer ? (which ? 15 : 14) : (which ? 3 : 2)]; const float* gain = p.in[layer ? 13 : 1];
                    transpose_item(W, DFF, gain, layer ? Wgu2 : Wgu1, DM, 0, (n0 / 128) * 256 + which * 128 + (n0 % 128), kb * 64, n0, scr, lane); done = true; }
                if (!done) rr -= I_GU;
            }
            if (done) continue;
            if (rr < I_DN) { transpose_item(p.in[4], DM, nullptr, Wd1, DFF, 0, (rr % 32) * 32, (rr / 32) * 64, (rr % 32) * 32, scr, lane); continue; } rr -= I_DN;
            if (rr < I_DN) { transpose_item(p.in[16], DM, nullptr, Wd2, DFF, 0, (rr % 32) * 32, (rr / 32) * 64, (rr % 32) * 32, scr, lane); continue; } rr -= I_DN;
            if (rr < I_IN) { transpose_item(p.in[6], DIN, p.in[5], Win, DM, 0, (rr % 160) * 32, (rr / 160) * 64, (rr % 160) * 32, scr, lane); continue; } rr -= I_IN;
            if (rr < I_BA) { transpose_item(p.in[8], DM, nullptr, Wbr, 768, 0, (rr % 32) * 32, (rr / 32) * 64, (rr % 32) * 32, scr, lane); continue; } rr -= I_BA;
            if (rr < I_BB) { transpose_item(p.in[9], DM, nullptr, Wbr, 768, 256, (rr % 32) * 32, (rr / 32) * 64, (rr % 32) * 32, scr, lane); continue; } rr -= I_BB;
            transpose_item(p.in[10], DM, nullptr, Wout, DM, 0, (rr % 32) * 32, (rr / 32) * 64, (rr % 32) * 32, scr, lane);
        }
        if (wg == 0) {
            const float* rel = p.in[12];
            for (int idx = tid; idx < 20 * LUTP; idx += 512) {
                const int hd = idx / LUTP, dist = idx % LUTP - 32;
                const int dil = (hd < 4) ? 1 : ((hd < 8) ? 4 : ((hd < 12) ? 16 : 1));
                const int maxs = (hd < 12) ? 128 : 127;
                float v = NEGBIG;
                if (dist >= 0 && dist <= maxs) {
                    const int n = dist * dil; int bucket;
                    if (n < 16) bucket = n;
                    else { const float nf = (float)n; int lg = 16 + (int)(logf(nf / 16.0f) / 4.852030263919617f * 16.0f); bucket = lg < 31 ? lg : 31; }
                    v = rel[bucket * 20 + hd] * LOG2E;
                }
                lutg[idx] = v;
            }
        }
        norm_rows_bf16(p.in[0], XN, RS, gw, ngw, lane);
    }
    if (G > (1 << 24)) grid.sync();
    xcd_barrier(xbar); TSTAMP(1);
#ifdef DBG_XCC
    if (threadIdx.x == 0) { const unsigned xcc = (unsigned)__builtin_amdgcn_s_getreg((3 << 11) | 20) & 0xFu; if (xcc != (unsigned)(wg & 7)) atomicAdd((unsigned*)(p.ws + MiB + 4096), 1u); }
#endif
    REP(1) if (PH(1)) { pg8::Gemm g{XN, Wgu1, MTOK, 2 * DFF, DM, DM, 1, GDBG(1)}; pg8::StaticOrder S; S.init(MTOK, 2 * DFF, G, wg); pg8::EpiSwiGLU E{HID, nullptr}; pg8::gemm_phase<pg8::EpiSwiGLU, (DBG_GEMM_PHASE == 1)>(lds, g, S, E); }
    xcd_barrier(xbar); TSTAMP(2);
    REP(2) if (PH(2)) { pg8::Gemm g{HID, Wd1, MTOK, DM, DFF, DFF, 1, GDBG(2)}; pg8::StaticOrder S; S.init(MTOK, DM, G, wg); pg8::EpiHB E{XN, RS, HB, SSQ, 0.5f}; pg8::gemm_phase<pg8::EpiHB, (DBG_GEMM_PHASE == 2)>(lds, g, S, E); }
    xcd_barrier(xbar); TSTAMP(3);
    REP(3) if (PH(3)) rowscale_phase(SSQ, RS, wg * 512 + otid(), G * 512);
    xcd_barrier(xbar); TSTAMP(4);
    REP(4) if (PH(4)) { pg8::Gemm g{HB, Win, MTOK, DIN, DM, DM, 1, GDBG(4)}; pg8::StaticOrder S; S.init(MTOK, DIN, G, wg); pg8::EpiZ E{Z, p.in[7], RS}; pg8::gemm_phase<pg8::EpiZ, (DBG_GEMM_PHASE == 4)>(lds, g, S, E); }
    xcd_barrier(xbar); TSTAMP(5);
    REP(5) if (PH(5)) attn_phase(lds, Z, YAB, LSE, lutg, p.in[11], G, wg);
    xcd_barrier(xbar); TSTAMP(6);
    REP(6) if (PH(6)) combine_phase(Z, LSE, YAB, wg * 512 + otid(), G * 512);
    xcd_barrier(xbar); TSTAMP(7);
    REP(7) if (PH(7)) { pg8::Gemm g{YAB, Wbr, MTOK, DM, 768, 768, 1, GDBG(7)}; pg8::StaticOrder S; S.init(MTOK, DM, G, wg); pg8::EpiMerge E{Z + ZO_KA, Z}; pg8::gemm_phase<pg8::EpiMerge, (DBG_GEMM_PHASE == 7)>(lds, g, S, E); }
    xcd_barrier(xbar); TSTAMP(8);
    REP(8) if (PH(8)) { pg8::Gemm g{Z + ZO_KA, Wout, MTOK, DM, DM, DM, 1, GDBG(8)}; pg8::StaticOrder S; S.init(MTOK, DM, G, wg); pg8::EpiHB E{HB, nullptr, HB, SSQ, 1.0f}; pg8::gemm_phase<pg8::EpiHB, (DBG_GEMM_PHASE == 8)>(lds, g, S, E); }
    xcd_barrier(xbar); TSTAMP(9);
    REP(9) if (PH(9)) rowscale_phase(SSQ, RS, wg * 512 + otid(), G * 512);
    xcd_barrier(xbar); TSTAMP(10);
    REP(10) if (PH(10)) { pg8::Gemm g{HB, Wgu2, MTOK, 2 * DFF, DM, DM, 1, GDBG(10)}; pg8::StaticOrder S; S.init(MTOK, 2 * DFF, G, wg); pg8::EpiSwiGLU E{HID, RS}; pg8::gemm_phase<pg8::EpiSwiGLU, (DBG_GEMM_PHASE == 10)>(lds, g, S, E); }
    xcd_barrier(xbar); TSTAMP(11);
    REP(11) if (PH(11)) { pg8::Gemm g{HID, Wd2, MTOK, DM, DFF, DFF, 1, GDBG(11)}; pg8::StaticOrder S; S.init(MTOK, DM, G, wg); pg8::EpiHB E{HB, nullptr, HB, SSQ, 0.5f}; pg8::gemm_phase<pg8::EpiHB, (DBG_GEMM_PHASE == 11)>(lds, g, S, E); }
    xcd_barrier(xbar); TSTAMP(12);
    REP(12) if (PH(12)) {
        PHASE_IDS
        const float* gf = p.in[17];
        f32x4 gv[4];
#pragma unroll
        for (int j = 0; j < 4; ++j) gv[j] = *((const f32x4*)gf + lane + 64 * j);
        for (int m = 2 * gw; m < MTOK; m += 2 * ngw) {
            u32x2 hv[2][4]; float ps[2];
#pragma unroll
            for (int q = 0; q < 2; ++q) {
#pragma unroll
                for (int j = 0; j < 4; ++j) hv[q][j] = *(const u32x2*)(HB + tiled_off(m + q, 4 * lane + 256 * j, DM / 64));
                ps[q] = SSQ[(size_t)(m + q) * 16 + (lane & 15)];
            }
#pragma unroll
            for (int q = 0; q < 2; ++q) {
                float sum = ps[q];
#pragma unroll
                for (int o = 1; o < 16; o <<= 1) sum += __shfl_xor(sum, o);
                const float r = 1.0f / sqrtf(sum * (1.0f / DM) + EPS);
                f32x4* orow = (f32x4*)(p.out + (size_t)(m + q) * DM) + lane;
#pragma unroll
                for (int j = 0; j < 4; ++j) { const u32x2 a = hv[q][j]; orow[64 * j] = (f32x4){bf_lo(a.x), bf_hi(a.x), bf_lo(a.y), bf_hi(a.y)} * r * gv[j]; }
            }
        }
    }
    if (DBG_A >= 0) {
        grid.sync();
        if (wg == 0) { const unsigned long long* tsp = (const unsigned long long*)(p.ws + MiB);
#ifdef DBG_XCC
            const long n = 100 + 10 * (long)(*((const unsigned*)(p.ws + MiB + 4096)));
#else
#ifdef DBG_CLOCK
            const long n = (long)((tsp[32 + DBG_B] - tsp[32 + DBG_A]) * 100 / (tsp[DBG_B] - tsp[DBG_A]));
#else
            const long n = DBG_GEMM_MODE ? (long)(tsp[20] / 10) : (long)(tsp[DBG_B >= 0 ? DBG_B : 0] - tsp[DBG_A >= 0 ? DBG_A : 0]) / 10;
#endif
#endif

            for (long i = threadIdx.x; i < n; i += 512) p.out[(size_t)i * 997 + 3] += 0.1f; }
    }
}

#undef Z
#undef XN
#undef HB
#undef RS
#undef SSQ
#undef YAB
#undef HID
#undef LSE
#undef lutg
extern "C" void kernel_launch(void* const* d_in, const int* in_sizes, int n_in, void* d_out, int out_size, void* d_ws, size_t ws_size, hipStream_t stream) {
    static int grid = 0;
    if (grid == 0) {
        if (n_in != 18 || out_size != MTOK * DM || ws_size < WS_END) { fprintf(stderr, "kernel_launch: unexpected shapes (n_in %d out %d ws %zu)\n", n_in, out_size, ws_size); grid = -1; return; }
        int dev = 0, cus = 0, per_cu = 0;
        if (hipGetDevice(&dev) != hipSuccess || hipDeviceGetAttribute(&cus, hipDeviceAttributeMultiprocessorCount, dev) != hipSuccess) { grid = -1; return; }
        if (hipFuncSetAttribute((const void*)fwd_kernel, hipFuncAttributeMaxDynamicSharedMemorySize, LDS_BYTES) != hipSuccess) { fprintf(stderr, "hipFuncSetAttribute failed\n"); grid = -1; return; }
        if (hipOccupancyMaxActiveBlocksPerMultiprocessor(&per_cu, (const void*)fwd_kernel, 512, LDS_BYTES) != hipSuccess || per_cu < 1) per_cu = 1;
        (void)hipGetLastError();
        grid = cus * per_cu;
    }
    if (grid < 0) return;
    if (hipMemsetAsync(d_ws, 0, XCD_BAR_WORDS * 4, stream) != hipSuccess) { fprintf(stderr, "memset failed\n"); return; }
    Params p{};
    for (int i = 0; i < 18; ++i) p.in[i] = (const float*)d_in[i];
    p.out = (float*)d_out; p.ws = (unsigned char*)d_ws;
    void* args[] = {&p};
    hipError_t e = hipLaunchCooperativeKernel((const void*)fwd_kernel, dim3(grid), dim3(512), args, LDS_BYTES, stream);
    if (e != hipSuccess) fprintf(stderr, "cooperative launch failed: %s (grid %d)\n", hipGetErrorString(e), grid);
}
```
